# Optimizing an MI355X kernel written in HIP

```python
import math
import jax, jax.numpy as jnp
from jax import lax
import numpy as np

D_MODEL = 1024
BATCH = 8
SEQ = 4096
DEPTH = 2

MEM_LEN = 256
NORM_EPS = 1e-6
N_BRANCH = 4
BRANCH_WIDTH = 256

MLA_HEADS = 4
MLA_Q_RANK = 256
MLA_KV_RANK = 128
MLA_NOPE = 64
MLA_ROPE = 32
MLA_V = 64
ROPE_THETA = 10000.0
ATTN_BLOCK = 128

SG_GROUPS = 4
SG_WIDTH = 256
SG_CHUNK = 128

GLA_HEADS = 4
GLA_DK = 32
GLA_DV = 64
GLA_GATE_RANK = 16
GLA_GATE_TEMP = 16.0
GLA_CHUNK = 64

DN_HEADS = 4
DN_DK = 64
DN_DV = 64
DN_CONV = 4
DN_CHUNK = 64

XATTN_HEADS = 4
XATTN_DIM = D_MODEL // XATTN_HEADS
MLP_HIDDEN = 4 * D_MODEL

IN_SIZES = (
    MLA_Q_RANK, MLA_KV_RANK, MLA_ROPE,
    2 * SG_WIDTH,
    GLA_HEADS * GLA_DK, GLA_HEADS * GLA_DK, GLA_HEADS * GLA_DV,
    GLA_GATE_RANK, GLA_HEADS * GLA_DV,
    DN_HEADS * DN_DK, DN_HEADS * DN_DK, DN_HEADS * DN_DV,
    DN_HEADS, DN_HEADS, DN_HEADS * DN_DV,
    N_BRANCH * D_MODEL,
)
IN_WIDTH = sum(IN_SIZES)

kernel_name = 'hybrid_parallel_mixer_decoder'


def rmsnorm(x, g, eps=NORM_EPS):
    xf = x.astype(jnp.float32)
    y = xf * lax.rsqrt(jnp.mean(xf * xf, axis=-1, keepdims=True) + eps)
    return (y * g).astype(x.dtype)


def layernorm(x, g, b, eps=NORM_EPS):
    xf = x.astype(jnp.float32)
    mu = jnp.mean(xf, axis=-1, keepdims=True)
    xc = xf - mu
    y = xc * lax.rsqrt(jnp.mean(xc * xc, axis=-1, keepdims=True) + eps)
    return (y * g + b).astype(x.dtype)


def l2norm(x, eps=NORM_EPS):
    return x * lax.rsqrt(jnp.sum(x * x, axis=-1, keepdims=True) + eps)


def rope_angles(positions, dim):
    inv_freq = ROPE_THETA ** (-jnp.arange(0, dim, 2, dtype=jnp.float32) / dim)
    ang = positions.astype(jnp.float32)[..., None] * inv_freq
    return jnp.cos(ang), jnp.sin(ang)


def apply_rope(x, cos, sin):
    half = x.shape[-1] // 2
    x1 = x[..., :half].astype(jnp.float32)
    x2 = x[..., half:].astype(jnp.float32)
    return jnp.concatenate([x1 * cos - x2 * sin, x2 * cos + x1 * sin], axis=-1).astype(x.dtype)


def to_chunks(t, chunk):
    b, s, h = t.shape[:3]
    t = t.reshape((b, s // chunk, chunk, h) + t.shape[3:])
    return t.transpose((1, 0, 3, 2) + tuple(range(4, t.ndim)))


def from_chunks(t):
    n, b, h, c = t.shape[:4]
    t = t.transpose((1, 0, 3, 2) + tuple(range(4, t.ndim)))
    return t.reshape((b, n * c, h) + t.shape[4:])


def causal_block_attention(q, k, v, scale):
    s_len = q.shape[2]
    outs = []
    for start in range(0, s_len, ATTN_BLOCK):
        end = start + ATTN_BLOCK
        s = jnp.einsum('bhqd,bhkd->bhqk', q[:, :, start:end], k[:, :, :end]).astype(jnp.float32) * scale
        qi = start + jnp.arange(ATTN_BLOCK)
        ki = jnp.arange(end)
        s = jnp.where(qi[:, None] >= ki[None, :], s, -jnp.inf)
        p = jax.nn.softmax(s, axis=-1).astype(v.dtype)
        outs.append(jnp.einsum('bhqk,bhkd->bhqd', p, v[:, :, :end]))
    return jnp.concatenate(outs, axis=2)


def mla_branch(cq, ckv, kpe, positions, norm_q, norm_kv, w_uq, w_ukv):
    b, s, _ = cq.shape
    h = MLA_HEADS
    q = (rmsnorm(cq, norm_q) @ w_uq).reshape(b, s, h, MLA_NOPE + MLA_ROPE)
    kv = (rmsnorm(ckv, norm_kv) @ w_ukv).reshape(b, s, h, MLA_NOPE + MLA_V)
    q_nope, q_pe = q[..., :MLA_NOPE], q[..., MLA_NOPE:]
    k_nope, v = kv[..., :MLA_NOPE], kv[..., MLA_NOPE:]
    cos, sin = rope_angles(positions, MLA_ROPE)
    q_pe = apply_rope(q_pe, cos[:, :, None, :], sin[:, :, None, :])
    k_pe = apply_rope(kpe, cos, sin)
    q = jnp.concatenate([q_nope, q_pe], axis=-1).transpose(0, 2, 1, 3)
    k = jnp.concatenate([k_nope, jnp.broadcast_to(k_pe[:, :, None, :], (b, s, h, MLA_ROPE))],
                        axis=-1).transpose(0, 2, 1, 3)
    v = v.transpose(0, 2, 1, 3)
    o = causal_block_attention(q, k, v, (MLA_NOPE + MLA_ROPE) ** -0.5)
    return o.transpose(0, 2, 1, 3).reshape(b, s, h * MLA_V)


def spatial_gating_branch(uv, ln_g, ln_b, w_s, b_s):
    b, s, _ = uv.shape
    uv = jax.nn.gelu(uv)
    u, v = uv[..., :SG_WIDTH], uv[..., SG_WIDTH:]
    v = layernorm(v, ln_g, ln_b)
    n = s // SG_CHUNK
    v = v.reshape(b, n, SG_CHUNK, SG_GROUPS, SG_WIDTH // SG_GROUPS)
    mask = jnp.tril(jnp.ones((SG_CHUNK, SG_CHUNK), dtype=w_s.dtype))
    mixed = jnp.einsum('gij,bnjgc->bnigc', w_s * mask, v) + b_s.T[:, :, None]
    return u * mixed.reshape(b, s, SG_WIDTH)


def gla_branch(q, k, v, gate_lr, out_gate, w_gate, b_gate, norm_o):
    b, s, _ = q.shape
    h, c = GLA_HEADS, GLA_CHUNK
    f32 = jnp.float32
    log_a = jax.nn.log_sigmoid((gate_lr @ w_gate + b_gate).astype(f32)) / GLA_GATE_TEMP
    q = q.astype(f32).reshape(b, s, h, GLA_DK) * (GLA_DK ** -0.5)
    k = k.astype(f32).reshape(b, s, h, GLA_DK)
    v = v.astype(f32).reshape(b, s, h, GLA_DV)
    log_a = log_a.reshape(b, s, h, GLA_DK)
    qc, kc, vc, ac = (to_chunks(t, c) for t in (q, k, v, log_a))
    idx = jnp.arange(c)
    incl = (idx[:, None] >= idx[None, :])[:, :, None]

    def step(state, inp):
        qi, ki, vi, ai = inp
        cum = jnp.cumsum(ai, axis=2)
        diff = cum[:, :, :, None, :] - cum[:, :, None, :, :]
        decay = jnp.where(incl, jnp.exp(jnp.where(incl, diff, 0.0)), 0.0)
        scores = jnp.einsum('bhik,bhjk,bhijk->bhij', qi, ki, decay)
        o = (jnp.einsum('bhik,bhkv->bhiv', qi * jnp.exp(cum), state)
             + jnp.einsum('bhij,bhjv->bhiv', scores, vi))
        last = cum[:, :, -1:, :]
        state = (jnp.exp(last[:, :, 0, :])[..., None] * state
                 + jnp.einsum('bhjk,bhjv->bhkv', ki * jnp.exp(last - cum), vi))
        return state, o

    state0 = jnp.zeros((b, h, GLA_DK, GLA_DV), f32)
    _, o = lax.scan(step, state0, (qc, kc, vc, ac))
    o = from_chunks(o)
    o = rmsnorm(o, norm_o) * jax.nn.silu(out_gate.astype(f32).reshape(b, s, h, GLA_DV))
    return o.reshape(b, s, h * GLA_DV)


def causal_depthwise_conv(x, w):
    return lax.conv_general_dilated(x, w[:, None, :], window_strides=(1,),
                                    padding=[(DN_CONV - 1, 0)],
                                    dimension_numbers=('NWC', 'WIO', 'NWC'),
                                    feature_group_count=x.shape[-1])


def deltanet_branch(q, k, v, a, bt, z, conv_w, a_log, dt_bias, norm_o):
    b, s, _ = q.shape
    h, c = DN_HEADS, DN_CHUNK
    f32 = jnp.float32
    qkv = jax.nn.silu(causal_depthwise_conv(jnp.concatenate([q, k, v], axis=-1), conv_w))
    q, k, v = jnp.split(qkv, [h * DN_DK, 2 * h * DN_DK], axis=-1)
    q = l2norm(q.astype(f32).reshape(b, s, h, DN_DK)) * (DN_DK ** -0.5)
    k = l2norm(k.astype(f32).reshape(b, s, h, DN_DK))
    v = v.astype(f32).reshape(b, s, h, DN_DV)
    beta = jax.nn.sigmoid(bt.astype(f32))
    g = -jnp.exp(a_log.astype(f32)) * jax.nn.softplus(a.astype(f32) + dt_bias.astype(f32))
    qc, kc, vc = (to_chunks(t, c) for t in (q, k, v))
    beta_c, g_c = to_chunks(beta, c), to_chunks(g, c)
    gam = jnp.cumsum(g_c, axis=-1)
    idx = jnp.arange(c)
    incl = idx[:, None] >= idx[None, :]
    strict = idx[:, None] > idx[None, :]
    diff = gam[..., :, None] - gam[..., None, :]
    dec_incl = jnp.where(incl, jnp.exp(jnp.where(incl, diff, 0.0)), 0.0)
    dec_strict = jnp.where(strict, dec_incl, 0.0)
    kk = jnp.einsum('nbhid,nbhjd->nbhij', kc, kc)
    lower = jnp.eye(c, dtype=f32) + beta_c[..., :, None] * kk * dec_strict
    rhs = jnp.concatenate([beta_c[..., None] * vc, (beta_c * jnp.exp(gam))[..., None] * kc], axis=-1)
    sol = lax.linalg.triangular_solve(lower, rhs, left_side=True, lower=True, unit_diagonal=True)
    w_c, x_c = sol[..., :DN_DV], sol[..., DN_DV:]
    attn = jnp.einsum('nbhid,nbhjd->nbhij', qc, kc) * dec_incl
    q_dec = qc * jnp.exp(gam)[..., None]
    k_dec = kc * jnp.exp(gam[..., -1:] - gam)[..., None]
    g_last = jnp.exp(gam[..., -1])

    def step(state, inp):
        w_i, x_i, attn_i, qd_i, kd_i, gl_i = inp
        u = w_i - jnp.einsum('bhck,bhkv->bhcv', x_i, state)
        o = jnp.einsum('bhck,bhkv->bhcv', qd_i, state) + jnp.einsum('bhij,bhjv->bhiv', attn_i, u)
        state = gl_i[..., None, None] * state + jnp.einsum('bhjk,bhjv->bhkv', kd_i, u)
        return state, o

    state0 = jnp.zeros((b, h, DN_DK, DN_DV), f32)
    _, o = lax.scan(step, state0, (w_c, x_c, attn, q_dec, k_dec, g_last))
    o = from_chunks(o)
    o = rmsnorm(o, norm_o) * jax.nn.silu(z.astype(f32).reshape(b, s, h, DN_DV))
    return o.reshape(b, s, h * DN_DV)


def mixer_block(h, positions, w_in, mla_norm_q, mla_norm_kv, mla_w_uq, mla_w_ukv,
                sg_ln_g, sg_ln_b, sg_w, sg_b, gla_w_gate, gla_b_gate, gla_norm,
                dn_conv, dn_a_log, dn_dt_bias, dn_norm, w_branch, w_out):
    b, s, _ = h.shape
    zin = h @ w_in
    splits = [int(i) for i in np.cumsum(IN_SIZES)[:-1]]
    (cq, ckv, kpe, sg_uv, gq, gk, gv, g_lr, g_og,
     dq, dk, dv, da, db, dz, gates) = jnp.split(zin, splits, axis=-1)
    o_a = mla_branch(cq, ckv, kpe, positions, mla_norm_q, mla_norm_kv, mla_w_uq, mla_w_ukv)
    o_b = spatial_gating_branch(sg_uv, sg_ln_g, sg_ln_b, sg_w, sg_b)
    o_c = gla_branch(gq, gk, gv, g_lr, g_og, gla_w_gate, gla_b_gate, gla_norm)
    o_d = deltanet_branch(dq, dk, dv, da, db, dz, dn_conv, dn_a_log, dn_dt_bias, dn_norm)
    branches = jnp.stack([o.astype(h.dtype) for o in (o_a, o_b, o_c, o_d)], axis=2)
    proj = jnp.einsum('bsnw,nwd->bsnd', branches, w_branch)
    gate = jax.nn.sigmoid(gates).reshape(b, s, N_BRANCH, D_MODEL)
    merged = jnp.sum(gate * proj, axis=2)
    return merged @ w_out


def cross_attention(h, mem_n, wq, wk, wv, wo):
    b, s, _ = h.shape
    m = mem_n.shape[1]
    q = (h @ wq).reshape(b, s, XATTN_HEADS, XATTN_DIM)
    k = (mem_n @ wk).reshape(b, m, XATTN_HEADS, XATTN_DIM)
    v = (mem_n @ wv).reshape(b, m, XATTN_HEADS, XATTN_DIM)
    sc = jnp.einsum('bshd,bmhd->bhsm', q, k).astype(jnp.float32) * (XATTN_DIM ** -0.5)
    p = jax.nn.softmax(sc, axis=-1).astype(v.dtype)
    o = jnp.einsum('bhsm,bmhd->bshd', p, v).reshape(b, s, XATTN_HEADS * XATTN_DIM)
    return o @ wo


def squared_relu_mlp(h, w_up, w_down):
    a = jax.nn.relu(h @ w_up)
    return (a * a) @ w_down


def setup_inputs(seed: int = 0) -> dict:
    key = jax.random.key(seed)
    ks = iter(jax.random.split(key, 48))
    f32 = jnp.float32
    L = DEPTH

    def nrm(shape, scale):
        return jax.random.normal(next(ks), shape, f32) * scale

    def gain(shape):
        return 1.0 + 0.1 * jax.random.normal(next(ks), shape, f32)

    x = nrm((BATCH, SEQ, D_MODEL), 1.0)
    mem = nrm((BATCH, MEM_LEN, D_MODEL), 1.0)
    offsets = jax.random.randint(next(ks), (BATCH, 1), 0, 1024, dtype=jnp.int32)
    positions = (offsets + jnp.arange(SEQ, dtype=jnp.int32)[None, :]).astype(jnp.int32)
    dn_ch = 2 * DN_HEADS * DN_DK + DN_HEADS * DN_DV
    a_init = jax.random.uniform(next(ks), (L, DN_HEADS), f32, 1.0, 16.0)
    dt = jnp.exp(jax.random.uniform(next(ks), (L, DN_HEADS), f32, math.log(1e-3), math.log(1e-1)))
    return {
        'x': x,
        'mem': mem,
        'positions': positions,
        'norm_mix': gain((L, D_MODEL)),
        'w_in': nrm((L, D_MODEL, IN_WIDTH), D_MODEL ** -0.5),
        'mla_norm_q': gain((L, MLA_Q_RANK)),
        'mla_norm_kv': gain((L, MLA_KV_RANK)),
        'mla_w_uq': nrm((L, MLA_Q_RANK, MLA_HEADS * (MLA_NOPE + MLA_ROPE)), MLA_Q_RANK ** -0.5),
        'mla_w_ukv': nrm((L, MLA_KV_RANK, MLA_HEADS * (MLA_NOPE + MLA_V)), MLA_KV_RANK ** -0.5),
        'sg_ln_g': gain((L, SG_WIDTH)),
        'sg_ln_b': nrm((L, SG_WIDTH), 0.02),
        'sg_w': nrm((L, SG_GROUPS, SG_CHUNK, SG_CHUNK), SG_CHUNK ** -0.5),
        'sg_b': 1.0 + nrm((L, SG_GROUPS, SG_CHUNK), 0.1),
        'gla_w_gate': nrm((L, GLA_GATE_RANK, GLA_HEADS * GLA_DK), GLA_GATE_RANK ** -0.5),
        'gla_b_gate': nrm((L, GLA_HEADS * GLA_DK), 0.1),
        'gla_norm': gain((L, GLA_DV)),
        'dn_conv': nrm((L, DN_CONV, dn_ch), DN_CONV ** -0.5),
        'dn_a_log': jnp.log(a_init),
        'dn_dt_bias': dt + jnp.log(-jnp.expm1(-dt)),
        'dn_norm': gain((L, DN_DV)),
        'w_branch': nrm((L, N_BRANCH, BRANCH_WIDTH, D_MODEL), BRANCH_WIDTH ** -0.5),
        'w_out': nrm((L, D_MODEL, D_MODEL), D_MODEL ** -0.5),
        'norm_xattn': gain((L, D_MODEL)),
        'norm_mem': gain((L, D_MODEL)),
        'xattn_wq': nrm((L, D_MODEL, XATTN_HEADS * XATTN_DIM), D_MODEL ** -0.5),
        'xattn_wk': nrm((L, D_MODEL, XATTN_HEADS * XATTN_DIM), D_MODEL ** -0.5),
        'xattn_wv': nrm((L, D_MODEL, XATTN_HEADS * XATTN_DIM), D_MODEL ** -0.5),
        'xattn_wo': nrm((L, XATTN_HEADS * XATTN_DIM, D_MODEL), D_MODEL ** -0.5),
        'norm_mlp': gain((L, D_MODEL)),
        'w_up': nrm((L, D_MODEL, MLP_HIDDEN), D_MODEL ** -0.5),
        'w_down': nrm((L, MLP_HIDDEN, D_MODEL), MLP_HIDDEN ** -0.5),
        'norm_final': gain((D_MODEL,)),
    }


def reference(x, mem, positions, norm_mix, w_in, mla_norm_q, mla_norm_kv, mla_w_uq, mla_w_ukv,
              sg_ln_g, sg_ln_b, sg_w, sg_b, gla_w_gate, gla_b_gate, gla_norm,
              dn_conv, dn_a_log, dn_dt_bias, dn_norm, w_branch, w_out,
              norm_xattn, norm_mem, xattn_wq, xattn_wk, xattn_wv, xattn_wo,
              norm_mlp, w_up, w_down, norm_final):
    for l in range(DEPTH):
        h = rmsnorm(x, norm_mix[l])
        x = x + mixer_block(h, positions, w_in[l], mla_norm_q[l], mla_norm_kv[l], mla_w_uq[l], mla_w_ukv[l],
                            sg_ln_g[l], sg_ln_b[l], sg_w[l], sg_b[l], gla_w_gate[l], gla_b_gate[l], gla_norm[l],
                            dn_conv[l], dn_a_log[l], dn_dt_bias[l], dn_norm[l], w_branch[l], w_out[l])
        x = x + cross_attention(rmsnorm(x, norm_xattn[l]), rmsnorm(mem, norm_mem[l]),
                                xattn_wq[l], xattn_wk[l], xattn_wv[l], xattn_wo[l])
        x = x + squared_relu_mlp(rmsnorm(x, norm_mlp[l]), w_up[l], w_down[l])
    return rmsnorm(x, norm_final)
```

```cpp
#include <hip/hip_runtime.h>
#include <cstdio>
#include <cstdint>

namespace pg8 {
#define PG8_LAS __attribute__((address_space(3)))
typedef unsigned short bf16_t;
typedef short bf16x8 __attribute__((ext_vector_type(8)));
typedef float f32x4 __attribute__((ext_vector_type(4)));
typedef unsigned u32x4 __attribute__((ext_vector_type(4)));
typedef unsigned u32x2 __attribute__((ext_vector_type(2)));
constexpr int BM = 256, BK = 64, HALF = 128, HTB = HALF * BK * 2, STAGE_BYTES = 8 * HTB, NXCD = 8, WGM = 8;

__host__ __device__ __forceinline__ int lds_byte(int r, int c) { const int st = (r >> 4) * 2 + (c >> 5), rr = r & 15, cc = c & 31, ob = rr * 64 + cc * 2; return st * 1024 + (ob ^ (((ob >> 9) & 1) << 5)); }
__host__ __device__ __forceinline__ void stage_rc(int b, int& R, int& C) { const int st = b / 1024, sb = b % 1024, swz = sb ^ (((sb >> 9) & 1) << 5); R = (st >> 1) * 16 + swz / 64; C = (st & 1) * 32 + (swz % 64) / 2; }
__host__ __device__ __forceinline__ int perm32(int rho) { const int n = rho >> 4, i = rho & 15; return 8 * (i >> 2) + 4 * n + (i & 3); }

struct Unit { int pm, pn; };
struct Gemm { const bf16_t* A; const bf16_t* A2; const bf16_t* Bt; int lda; int M, N, K; int ksplit; int agrp; };

struct StaticOrder {
    int nM, nN, nwg, G, c;
    __host__ __device__ __forceinline__ void init(int M, int N, int G_, int c_) { nM = M / BM; nN = N / BM; nwg = nM * nN; G = G_; c = c_; }
    __host__ __device__ __forceinline__ bool next(int i, Unit& u) const {
        const long L = (long)i * G + c; if (L >= nwg) return false;
        int wgid = (int)L; { const int q = nwg / NXCD, r = nwg % NXCD, xcd = wgid % NXCD, off = wgid / NXCD; wgid = (xcd < r ? xcd * (q + 1) : r * (q + 1) + (xcd - r) * q) + off; }
        const int nig = WGM * nN, gid = wgid / nig, fm = gid * WGM, gsz = (nM - fm) < WGM ? (nM - fm) : WGM;
        u.pm = fm + ((wgid % nig) % gsz); u.pn = (wgid % nig) / gsz; return true;
    }
    __device__ __forceinline__ void a_ready(const Unit&) const {}
    __device__ __forceinline__ void done(const Unit&) const {}
};

typedef float f32x2_t __attribute__((ext_vector_type(2))); typedef __bf16 bf16x2_t __attribute__((ext_vector_type(2)));
__device__ __forceinline__ unsigned cvt_pk_bf16(float lo, float hi) { f32x2_t v = {lo, hi}; bf16x2_t b = __builtin_convertvector(v, bf16x2_t); return __builtin_bit_cast(unsigned, b); }

__device__ __forceinline__ float row_rscale(const float* ss, size_t row) { const f32x4 a = *(const f32x4*)(ss + row * 16), b = *(const f32x4*)(ss + row * 16 + 4), c = *(const f32x4*)(ss + row * 16 + 8), d = *(const f32x4*)(ss + row * 16 + 12);
    const float t = ((a[0] + a[1]) + (a[2] + a[3])) + ((b[0] + b[1]) + (b[2] + b[3])) + ((c[0] + c[1]) + (c[2] + c[3])) + ((d[0] + d[1]) + (d[2] + d[3])); return 1.0f / sqrtf(t * (1.f / 1024.f) + 1e-6f); }
__device__ __forceinline__ void row_rscale8(const float* ss, int row0, int fq, float (&r)[8]) {
    f32x4 p[8];
#pragma unroll
    for (int i = 0; i < 8; ++i) p[i] = *(const f32x4*)(ss + (size_t)(row0 + (i >> 2) * HALF + (i & 3) * 16) * 16 + 4 * fq);
#pragma unroll
    for (int i = 0; i < 8; ++i) { float t = (p[i][0] + p[i][1]) + (p[i][2] + p[i][3]); t += __shfl_xor(t, 16); t += __shfl_xor(t, 32); r[i] = 1.0f / sqrtf(t * (1.f / 1024.f) + 1e-6f); }
}
template <int ACT> struct EpiBf16 {
    static constexpr bool PERM = true, AFTER_DRAIN = false, HAS_MID = false;
    bf16_t* O; int ldc; float scale; const float* ss; const float* rsrc; float* rout;
    __device__ __forceinline__ void mid(f32x4 (&)[2][2][4][2], const Unit&, int, int, int, int) const {}
    __device__ __forceinline__ void operator()(const f32x4 (&acc)[2][2][4][2], const Unit& u, int wr, int wc, int fr, int fq) const {
        { int t_ = threadIdx.x; asm volatile("" : "+v"(t_)); fr = t_ & 15; fq = (t_ >> 4) & 3; }
        const int row0 = u.pm * BM + wr * 64 + fr; const int col0 = u.pn * BM + wc * 32 + 8 * fq;
        float rs8[8];
        if (rout && u.pn == 0 && wc == 0) { row_rscale8(rsrc, row0, fq, rs8);
            if (fq == 0) {
#pragma unroll
                for (int i = 0; i < 8; ++i) rout[row0 + (i >> 2) * HALF + (i & 3) * 16] = rs8[i]; } }
        if (ss) { row_rscale8(ss, row0, fq, rs8);
#pragma unroll
            for (int i = 0; i < 8; ++i) rs8[i] = scale * ((ACT == 2) ? rs8[i] * rs8[i] : rs8[i]); }
        else {
#pragma unroll
            for (int i = 0; i < 8; ++i) rs8[i] = scale; }
#pragma unroll
        for (int ai = 0; ai < 2; ++ai)
#pragma unroll
            for (int m = 0; m < 4; ++m) { const size_t row = (size_t)(row0 + ai * HALF + m * 16); bf16_t* rowp = O + row * ldc + col0;
                const float rs = rs8[ai * 4 + m];
#pragma unroll
                for (int bj = 0; bj < 2; ++bj) { f32x4 v0 = acc[ai][bj][m][0], v1 = acc[ai][bj][m][1];
                    if (ACT == 2) {
#pragma unroll
                        for (int j = 0; j < 4; ++j) { float a = v0[j] > 0.f ? v0[j] : 0.f; v0[j] = a * a; float b = v1[j] > 0.f ? v1[j] : 0.f; v1[j] = b * b; } }
                    v0 = v0 * rs; v1 = v1 * rs; u32x4 w; w.x = cvt_pk_bf16(v0[0], v0[1]); w.y = cvt_pk_bf16(v0[2], v0[3]); w.z = cvt_pk_bf16(v1[0], v1[1]); w.w = cvt_pk_bf16(v1[2], v1[3]);
                    *(u32x4*)(rowp + bj * HALF) = w; } }
    }
};
struct EpiZin {
    static constexpr bool PERM = true, AFTER_DRAIN = false, HAS_MID = false;
    bf16_t* ZA; bf16_t* ZB; float* SSQ; float* ZF; const float* ss;
    __device__ __forceinline__ void mid(f32x4 (&)[2][2][4][2], const Unit&, int, int, int, int) const {}
    __device__ __forceinline__ void operator()(const f32x4 (&acc)[2][2][4][2], const Unit& u, int wr, int wc, int fr, int fq) const {
        { int t_ = threadIdx.x; asm volatile("" : "+v"(t_)); fr = t_ & 15; fq = (t_ >> 4) & 3; }
        const int row0 = u.pm * BM + wr * 64 + fr; const int pn = u.pn;
        bf16_t* base = (pn < 4) ? ZA + pn * BM : ZB + (pn - 4) * BM; const int ldc = (pn < 4) ? 1024 : 1792;
        const int col0 = wc * 32 + 8 * fq;
        float rr8[8];
#pragma unroll
        for (int i = 0; i < 8; ++i) rr8[i] = ss[row0 + (i >> 2) * HALF + (i & 3) * 16];
#pragma unroll
        for (int ai = 0; ai < 2; ++ai)
#pragma unroll
            for (int m = 0; m < 4; ++m) { const int row = row0 + ai * HALF + m * 16; bf16_t* rowp = base + (size_t)row * ldc + col0; const float rr = rr8[ai * 4 + m];
#pragma unroll
                for (int bj = 0; bj < 2; ++bj) { const f32x4 v0 = acc[ai][bj][m][0] * rr, v1 = acc[ai][bj][m][1] * rr;
                    u32x4 w; w.x = cvt_pk_bf16(v0[0], v0[1]); w.y = cvt_pk_bf16(v0[2], v0[3]); w.z = cvt_pk_bf16(v1[0], v1[1]); w.w = cvt_pk_bf16(v1[2], v1[3]);
                    *(u32x4*)(rowp + bj * HALF) = w; }
                if (pn <= 1) { float s = 0.f;
#pragma unroll
                    for (int bj = 0; bj < 2; ++bj) if (bj == 0 || pn == 0) {
#pragma unroll
                        for (int n = 0; n < 2; ++n) { const f32x4 x = acc[ai][bj][m][n] * rr; s += (x[0] * x[0] + x[1] * x[1]) + (x[2] * x[2] + x[3] * x[3]); } }
                    s += __shfl_xor(s, 16); s += __shfl_xor(s, 32);
                    if (fq == 0) SSQ[(size_t)row * 8 + pn * 4 + wc] = s;
                    if (pn == 1 && wc == 1) { float* zf = ZF + (size_t)row * 32 + 8 * fq; *(f32x4*)zf = acc[ai][1][m][0] * rr; *(f32x4*)(zf + 4) = acc[ai][1][m][1] * rr; } }
            }
    }
};
struct EpiMla {
    static constexpr bool PERM = true, AFTER_DRAIN = false, HAS_MID = false;
    bf16_t* Q; bf16_t* K; bf16_t* V; const float* SSQ; const float* RC; const float* RS;
    __device__ __forceinline__ void mid(f32x4 (&)[2][2][4][2], const Unit&, int, int, int, int) const {}
    __device__ __forceinline__ void operator()(const f32x4 (&acc)[2][2][4][2], const Unit& u, int wr, int wc, int fr, int fq) const {
        { int t_ = threadIdx.x; asm volatile("" : "+v"(t_)); fr = t_ & 15; fq = (t_ >> 4) & 3; }
        const int row0 = u.pm * BM + wr * 64 + fr;
        float rq8[8], rkv8[8];
#pragma unroll
        for (int i = 0; i < 8; ++i) { const size_t t = (size_t)(row0 + (i >> 2) * HALF + (i & 3) * 16); rq8[i] = SSQ[t * 8 + fq]; rkv8[i] = SSQ[t * 8 + 4 + fq]; }
#pragma unroll
        for (int i = 0; i < 8; ++i) { float a = rq8[i], b2 = rkv8[i]; a += __shfl_xor(a, 16); b2 += __shfl_xor(b2, 16); a += __shfl_xor(a, 32); b2 += __shfl_xor(b2, 32);
            rq8[i] = 1.0f / sqrtf(a * (1.f / 256.f) + 1e-6f); rkv8[i] = 1.0f / sqrtf(b2 * (1.f / 128.f) + 1e-6f); }
        bool rope = false;
#pragma unroll
        for (int bj = 0; bj < 2; ++bj) { const int c32 = u.pn * BM + bj * HALF + wc * 32; rope = rope || (c32 < 384 ? (c32 % 96 == 64) : (c32 >= 896 && c32 < 928)); }
#pragma unroll
        for (int ai = 0; ai < 2; ++ai) {
            f32x4 cs4[4], sn4[4];
            if (rope) {
#pragma unroll
                for (int m = 0; m < 4; ++m) { const size_t t = (size_t)(row0 + ai * HALF + m * 16); cs4[m] = *(const f32x4*)(RC + t * 16 + 4 * fq); sn4[m] = *(const f32x4*)(RS + t * 16 + 4 * fq); } }
            else {
#pragma unroll
                for (int m = 0; m < 4; ++m) { cs4[m] = (f32x4){0.f, 0.f, 0.f, 0.f}; sn4[m] = cs4[m]; } }
#pragma unroll
            for (int m = 0; m < 4; ++m) { const size_t t = (size_t)(row0 + ai * HALF + m * 16);
                const float rq = rq8[ai * 4 + m], rkv = rkv8[ai * 4 + m];
#pragma unroll
                for (int bj = 0; bj < 2; ++bj) { const int c32 = u.pn * BM + bj * HALF + wc * 32;
                    const int c8 = c32 + 8 * fq; const f32x4 v0 = acc[ai][bj][m][0], v1 = acc[ai][bj][m][1];
                    if (c32 < 384) { const int h = c32 / 96, o32 = c32 - 96 * h;
                        if (o32 < 64) { const f32x4 a = v0 * rq, b = v1 * rq; u32x4 w; w.x = cvt_pk_bf16(a[0], a[1]); w.y = cvt_pk_bf16(a[2], a[3]); w.z = cvt_pk_bf16(b[0], b[1]); w.w = cvt_pk_bf16(b[2], b[3]);
                            *(u32x4*)(Q + t * 384 + c8) = w; }
                        else { const int jp = 4 * fq; const f32x4 cs = cs4[m], sn = sn4[m];
                            const float x10 = v0[0] * rq, x20 = v0[1] * rq, x11 = v0[2] * rq, x21 = v0[3] * rq, x12 = v1[0] * rq, x22 = v1[1] * rq, x13 = v1[2] * rq, x23 = v1[3] * rq;
                            u32x2 y1, y2; y1.x = cvt_pk_bf16(x10 * cs[0] - x20 * sn[0], x11 * cs[1] - x21 * sn[1]); y1.y = cvt_pk_bf16(x12 * cs[2] - x22 * sn[2], x13 * cs[3] - x23 * sn[3]);
                            y2.x = cvt_pk_bf16(x20 * cs[0] + x10 * sn[0], x21 * cs[1] + x11 * sn[1]); y2.y = cvt_pk_bf16(x22 * cs[2] + x12 * sn[2], x23 * cs[3] + x13 * sn[3]);
                            *(u32x2*)(Q + t * 384 + h * 96 + 64 + jp) = y1; *(u32x2*)(Q + t * 384 + h * 96 + 80 + jp) = y2; } }
                    else if (c32 < 896) { const int c = c8 - 384, h = c >> 7, o = c & 127; const f32x4 a = v0 * rkv, b = v1 * rkv;
                        u32x4 w; w.x = cvt_pk_bf16(a[0], a[1]); w.y = cvt_pk_bf16(a[2], a[3]); w.z = cvt_pk_bf16(b[0], b[1]); w.w = cvt_pk_bf16(b[2], b[3]);
                        if (o < 64) *(u32x4*)(K + t * 384 + h * 96 + o) = w;
                        else { bf16_t* vt = V + ((size_t)((t >> 12) * 4 + h) * 64 + (o - 64)) * 4096 + (t & 4095);
                            vt[0] = (bf16_t)w.x; vt[4096] = (bf16_t)(w.x >> 16); vt[2 * 4096] = (bf16_t)w.y; vt[3 * 4096] = (bf16_t)(w.y >> 16);
                            vt[4 * 4096] = (bf16_t)w.z; vt[5 * 4096] = (bf16_t)(w.z >> 16); vt[6 * 4096] = (bf16_t)w.w; vt[7 * 4096] = (bf16_t)(w.w >> 16); } }
                    else if (c32 < 928) { const int jp = 4 * fq; const f32x4 cs = cs4[m], sn = sn4[m];
                        u32x2 y1, y2; y1.x = cvt_pk_bf16(v0[0] * cs[0] - v0[1] * sn[0], v0[2] * cs[1] - v0[3] * sn[1]); y1.y = cvt_pk_bf16(v1[0] * cs[2] - v1[1] * sn[2], v1[2] * cs[3] - v1[3] * sn[3]);
                        y2.x = cvt_pk_bf16(v0[1] * cs[0] + v0[0] * sn[0], v0[3] * cs[1] + v0[2] * sn[1]); y2.y = cvt_pk_bf16(v1[1] * cs[2] + v1[0] * sn[2], v1[3] * cs[3] + v1[2] * sn[3]);
#pragma unroll
                        for (int h2 = 0; h2 < 4; ++h2) { *(u32x2*)(K + t * 384 + h2 * 96 + 64 + jp) = y1; *(u32x2*)(K + t * 384 + h2 * 96 + 80 + jp) = y2; } }
                }
            }
        }
    }
};
struct EpiBf16T {
    static constexpr bool PERM = true, AFTER_DRAIN = false, HAS_MID = false;
    bf16_t* O;
    __device__ __forceinline__ void mid(f32x4 (&)[2][2][4][2], const Unit&, int, int, int, int) const {}
    __device__ __forceinline__ void operator()(const f32x4 (&acc)[2][2][4][2], const Unit& u, int wr, int wc, int fr, int fq) const {
        const int row0 = u.pm * BM + wr * 64 + fr; const int col0 = u.pn * BM + wc * 32 + 8 * fq;
#pragma unroll
        for (int ai = 0; ai < 2; ++ai)
#pragma unroll
            for (int m = 0; m < 4; ++m) { const int row = row0 + ai * HALF + m * 16; bf16_t* bp = O + ((size_t)(row >> 8) * 1024 + col0) * 256 + (row & 255);
#pragma unroll
                for (int bj = 0; bj < 2; ++bj) { const f32x4 v0 = acc[ai][bj][m][0], v1 = acc[ai][bj][m][1]; bf16_t* p = bp + (size_t)(bj * HALF) * 256;
                    const unsigned w0 = cvt_pk_bf16(v0[0], v0[1]), w1 = cvt_pk_bf16(v0[2], v0[3]), w2 = cvt_pk_bf16(v1[0], v1[1]), w3 = cvt_pk_bf16(v1[2], v1[3]);
                    p[0] = (bf16_t)w0; p[256] = (bf16_t)(w0 >> 16); p[512] = (bf16_t)w1; p[768] = (bf16_t)(w1 >> 16); p[1024] = (bf16_t)w2; p[1280] = (bf16_t)(w2 >> 16); p[1536] = (bf16_t)w3; p[1792] = (bf16_t)(w3 >> 16); } }
    }
};
struct EpiResF32 {
    static constexpr bool PERM = true, AFTER_DRAIN = false, HAS_MID = false;
    bf16_t* xb; int ldc; float* ss; const float* ssin;
    __device__ __forceinline__ void mid(f32x4 (&)[2][2][4][2], const Unit&, int, int, int, int) const {}
    __device__ __forceinline__ void operator()(const f32x4 (&acc)[2][2][4][2], const Unit& u, int wr, int wc, int fr, int fq) const {
        { int t_ = threadIdx.x; asm volatile("" : "+v"(t_)); fr = t_ & 15; fq = (t_ >> 4) & 3; }
        const int row0 = u.pm * BM + wr * 64 + fr, col0 = u.pn * BM + wc * 32 + 8 * fq;
        float r28[8];
        if (ssin) {
#pragma unroll
            for (int i = 0; i < 8; ++i) { const float r = ssin[row0 + (i >> 2) * HALF + (i & 3) * 16]; r28[i] = r * r; } }
        else {
#pragma unroll
            for (int i = 0; i < 8; ++i) r28[i] = 1.f; }
        u32x4 xo8[8][2];
#pragma unroll
        for (int i = 0; i < 8; ++i) { const size_t off = (size_t)(row0 + (i >> 2) * HALF + (i & 3) * 16) * ldc + col0; xo8[i][0] = *(const u32x4*)(xb + off); xo8[i][1] = *(const u32x4*)(xb + off + HALF); }
#pragma unroll
        for (int ai = 0; ai < 2; ++ai)
#pragma unroll
            for (int m = 0; m < 4; ++m) { const size_t row = (size_t)(row0 + ai * HALF + m * 16); const size_t off = row * ldc + col0; float sq = 0.f; const float r2 = r28[ai * 4 + m];
#pragma unroll
                for (int bj = 0; bj < 2; ++bj) { const u32x4 xo = xo8[ai * 4 + m][bj];
                    f32x4 r0, r1; r0[0] = __uint_as_float(xo.x << 16); r0[1] = __uint_as_float(xo.x & 0xffff0000u); r0[2] = __uint_as_float(xo.y << 16); r0[3] = __uint_as_float(xo.y & 0xffff0000u);
                    r1[0] = __uint_as_float(xo.z << 16); r1[1] = __uint_as_float(xo.z & 0xffff0000u); r1[2] = __uint_as_float(xo.w << 16); r1[3] = __uint_as_float(xo.w & 0xffff0000u);
                    r0 += acc[ai][bj][m][0] * r2; r1 += acc[ai][bj][m][1] * r2;
                    u32x4 w; w.x = cvt_pk_bf16(r0[0], r0[1]); w.y = cvt_pk_bf16(r0[2], r0[3]); w.z = cvt_pk_bf16(r1[0], r1[1]); w.w = cvt_pk_bf16(r1[2], r1[3]); *(u32x4*)(xb + off + bj * HALF) = w;
                    const float q0 = __uint_as_float(w.x << 16), q1 = __uint_as_float(w.x & 0xffff0000u), q2 = __uint_as_float(w.y << 16), q3 = __uint_as_float(w.y & 0xffff0000u), q4 = __uint_as_float(w.z << 16), q5 = __uint_as_float(w.z & 0xffff0000u), q6 = __uint_as_float(w.w << 16), q7 = __uint_as_float(w.w & 0xffff0000u);
                    sq += ((q0 * q0 + q1 * q1) + (q2 * q2 + q3 * q3)) + ((q4 * q4 + q5 * q5) + (q6 * q6 + q7 * q7)); }
                sq += __shfl_xor(sq, 16); sq += __shfl_xor(sq, 32);
                if (fq == 0) ss[row * 16 + u.pn * 4 + wc] = sq; }
    }
};
struct EpiMerge {
    static constexpr bool PERM = false, AFTER_DRAIN = false, HAS_MID = false;
    bf16_t* MG; const bf16_t* P; const float* r1;
    __device__ __forceinline__ void mid(f32x4 (&)[2][2][4][2], const Unit&, int, int, int, int) const {}
    __device__ __forceinline__ void operator()(const f32x4 (&acc)[2][2][4][2], const Unit& u, int wr, int wc, int fr, int fq) const {
        { int t_ = threadIdx.x; asm volatile("" : "+v"(t_)); fr = t_ & 15; fq = (t_ >> 4) & 3; }
        const int row0 = u.pm * BM + wr * 64 + fr, col0 = u.pn * 64 + wc * 16 + 4 * fq;
        u32x2 pw8[8][4]; float rr8[8];
#pragma unroll
        for (int i = 0; i < 8; ++i) { const size_t row = (size_t)(row0 + (i >> 2) * HALF + (i & 3) * 16); rr8[i] = r1[row]; const bf16_t* pp = P + row * 4096 + col0;
#pragma unroll
            for (int gte = 0; gte < 4; ++gte) pw8[i][gte] = *(const u32x2*)(pp + gte * 1024); }
#pragma unroll
        for (int ai = 0; ai < 2; ++ai)
#pragma unroll
            for (int m = 0; m < 4; ++m) { const size_t row = (size_t)(row0 + ai * HALF + m * 16); const float rr = rr8[ai * 4 + m]; const u32x2* pw = pw8[ai * 4 + m];
                f32x4 sum = (f32x4){0.f, 0.f, 0.f, 0.f};
#pragma unroll
                for (int bj = 0; bj < 2; ++bj)
#pragma unroll
                    for (int n = 0; n < 2; ++n) { const f32x4 v = acc[ai][bj][m][n]; const u32x2 w = pw[2 * bj + n]; f32x4 p;
                        p[0] = __uint_as_float(w.x << 16); p[1] = __uint_as_float(w.x & 0xffff0000u); p[2] = __uint_as_float(w.y << 16); p[3] = __uint_as_float(w.y & 0xffff0000u);
#pragma unroll
                        for (int j = 0; j < 4; ++j) sum[j] += __builtin_amdgcn_rcpf(1.0f + __expf(-v[j] * rr)) * p[j]; }
                u32x2 o; o.x = cvt_pk_bf16(sum[0], sum[1]); o.y = cvt_pk_bf16(sum[2], sum[3]);
                *(u32x2*)(MG + row * 1024 + col0) = o; }
    }
};

template <class Epi, class Sched, bool ALIGN_EPI = false, bool SP2 = false>
__device__ __forceinline__ void gemm_phase(PG8_LAS unsigned char* lds, const Gemm g, const Sched& S, const Epi& E) {
    int tid = threadIdx.x; asm volatile("" : "+v"(tid)); const int wid = __builtin_amdgcn_readfirstlane(tid >> 6), lane = tid & 63, wr = wid >> 2, wc = wid & 3, fr = lane & 15, fq = lane >> 4;
    const int K = g.K, nt = K / BK, lda = g.lda, ksplit = g.ksplit;
    unsigned voffA[2], voffB[2];
#pragma unroll
    for (int i = 0; i < 2; ++i) { int R, C; stage_rc(tid * 16 + i * 8192, R, C); const int Rb = Epi::PERM ? ((R & ~31) + perm32(R & 31)) : R;
        voffA[i] = (unsigned)(R * lda + C) * 2u; voffB[i] = (unsigned)(Rb * K + C) * 2u; }
    const size_t kstep = (size_t)(BK * 2);
    const size_t hstepA = (size_t)HALF * lda * 2, tstepA = 2 * hstepA;
    const size_t hstepB = (size_t)HALF * K * 2, tstepB = 2 * hstepB;
    const long dA2 = g.A2 ? (long)((const char*)g.A2 - (const char*)g.A) - (long)ksplit * (long)kstep : 0L;
    const unsigned ldsw = (unsigned)wid * 1024u;
    const int aoff = lds_byte(wr * 64 + fr, fq * 8), boff = lds_byte(wc * 32 + fr, fq * 8);
#define PG8_SA(b, h) (((b) * 2 + (h)) * HTB)
#define PG8_SB(b, h) ((4 + (b) * 2 + (h)) * HTB)
#define PG8_STAGE(bufoff, gbase, voff) do { _Pragma("unroll") for (int _i = 0; _i < 2; ++_i) \
        __builtin_amdgcn_global_load_lds((const unsigned*)((const char*)(gbase) + (voff)[_i]), (PG8_LAS unsigned*)(lds + (bufoff) + ldsw + _i * 8192), 16, 0, 0); } while (0)
#define PG8_LDA(dst, b, h) do { _Pragma("unroll") for (int m = 0; m < 4; ++m) _Pragma("unroll") for (int k = 0; k < 2; ++k) dst[m][k] = *(const PG8_LAS bf16x8*)(lds + PG8_SA(b, h) + aoff + m * 2048 + k * 1024); } while (0)
#define PG8_LDB(dst, b, h) do { _Pragma("unroll") for (int n = 0; n < 2; ++n) _Pragma("unroll") for (int k = 0; k < 2; ++k) dst[n][k] = *(const PG8_LAS bf16x8*)(lds + PG8_SB(b, h) + boff + n * 2048 + k * 1024); } while (0)
#define PG8_MMA(ai, bj, At, Bt) do { __builtin_amdgcn_s_setprio(1); _Pragma("unroll") for (int m = 0; m < 4; ++m) _Pragma("unroll") for (int n = 0; n < 2; ++n) _Pragma("unroll") for (int k = 0; k < 2; ++k) \
        acc[ai][bj][m][n] = __builtin_amdgcn_mfma_f32_16x16x32_bf16(Bt[n][k], At[m][k], acc[ai][bj][m][n], 0, 0, 0); __builtin_amdgcn_s_setprio(0); } while (0)
#define PG8_MMAM(ai, bj, At, Bt) do { if constexpr (!Epi::HAS_MID) { PG8_MMA(ai, bj, At, Bt); } else { const bool e0 = (pgate < 0) || (pgate == 2 * (bj)), e1 = (pgate < 0) || (pgate == 2 * (bj) + 1); \
        __builtin_amdgcn_s_setprio(1); if (e0) { _Pragma("unroll") for (int m = 0; m < 4; ++m) _Pragma("unroll") for (int k = 0; k < 2; ++k) acc[ai][bj][m][0] = __builtin_amdgcn_mfma_f32_16x16x32_bf16(Bt[0][k], At[m][k], acc[ai][bj][m][0], 0, 0, 0); } \
        if (e1) { _Pragma("unroll") for (int m = 0; m < 4; ++m) _Pragma("unroll") for (int k = 0; k < 2; ++k) acc[ai][bj][m][1] = __builtin_amdgcn_mfma_f32_16x16x32_bf16(Bt[1][k], At[m][k], acc[ai][bj][m][1], 0, 0, 0); } __builtin_amdgcn_s_setprio(0); } } while (0)
#define PG8_WAIT_V(n) asm volatile("s_waitcnt vmcnt(" #n ")" ::: "memory")
#define PG8_WAIT_L(n) asm volatile("s_waitcnt lgkmcnt(" #n ")" ::: "memory")
#define PG8_BAR __builtin_amdgcn_s_barrier()
#define PG8_SCHED __builtin_amdgcn_sched_barrier(0)
#define PG8_AT(base, tt) ((base) + (size_t)(tt) * kstep + (((tt) >= ksplit) ? dA2 : 0L))
    Unit cur, nxt; int ui = 0;
    if (!S.next(0, cur)) return;
    f32x4 acc[2][2][4][2];
#pragma unroll
    for (int a = 0; a < 2; ++a)
#pragma unroll
        for (int b = 0; b < 2; ++b)
#pragma unroll
            for (int m = 0; m < 4; ++m)
#pragma unroll
                for (int n = 0; n < 2; ++n) acc[a][b][m][n] = (f32x4){0.f, 0.f, 0.f, 0.f};
    bf16x8 At[4][2], B0[2][2], B1[2][2];
    const char* cA = (const char*)g.A + (size_t)cur.pm * tstepA + (size_t)(cur.pn >> 2) * g.agrp; const char* cB = (const char*)g.Bt + (size_t)cur.pn * tstepB;
    S.a_ready(cur);
    if constexpr (SP2) {
        PG8_STAGE(PG8_SB(0, 0), cB, voffB); PG8_STAGE(PG8_SB(0, 1), cB + hstepB, voffB); PG8_STAGE(PG8_SA(0, 0), cA, voffA); PG8_STAGE(PG8_SA(0, 1), cA + hstepA, voffA);
        if (wr == 1) PG8_BAR;
        PG8_WAIT_V(2); PG8_BAR;
        PG8_STAGE(PG8_SB(1, 0), cB + kstep, voffB); PG8_STAGE(PG8_SA(1, 0), cA + kstep, voffA); PG8_STAGE(PG8_SB(1, 1), cB + hstepB + kstep, voffB);
        PG8_WAIT_V(6); PG8_BAR;
    } else {
        PG8_STAGE(PG8_SB(0, 0), cB, voffB); PG8_STAGE(PG8_SA(0, 0), cA, voffA); PG8_STAGE(PG8_SB(0, 1), cB + hstepB, voffB); PG8_STAGE(PG8_SA(0, 1), cA + hstepA, voffA);
        if (wr == 1) PG8_BAR;
        PG8_WAIT_V(4); PG8_BAR;
        PG8_STAGE(PG8_SB(1, 0), cB + kstep, voffB); PG8_STAGE(PG8_SA(1, 0), cA + kstep, voffA); PG8_STAGE(PG8_SB(1, 1), cB + hstepB + kstep, voffB);
        PG8_WAIT_V(6); PG8_BAR;
    }
    for (;;) {
        const bool has_next = S.next(ui + 1, nxt);
        const char* nA = has_next ? (const char*)g.A + (size_t)nxt.pm * tstepA + (size_t)(nxt.pn >> 2) * g.agrp : cA; const char* nB = has_next ? (const char*)g.Bt + (size_t)nxt.pn * tstepB : cB;
        for (int t = 0; t < nt; t += 2) {
            const bool last = (t == nt - 2);
            if constexpr (Epi::HAS_MID) { if (t == ksplit) E.mid(acc, cur, wr, wc, fr, fq); }
            const char* a1 = PG8_AT(cA, t + 1);
            const char* a2 = last ? nA : PG8_AT(cA, t + 2); const char* b2 = last ? nB : cB + (size_t)(t + 2) * kstep;
            const char* a3 = last ? nA + kstep : PG8_AT(cA, t + 3); const char* b3 = b2 + kstep;
            if (last && has_next) S.a_ready(nxt);
            const int pgate = (Epi::HAS_MID && t >= ksplit) ? ((t - ksplit) >> 2) : -1;
            if constexpr (SP2) {
            PG8_LDB(B0, 0, 0); PG8_LDB(B1, 0, 1); PG8_SCHED; PG8_LDA(At, 0, 0); PG8_STAGE(PG8_SA(1, 1), a1 + hstepA, voffA);
            PG8_WAIT_V(8); PG8_WAIT_L(0); PG8_BAR; PG8_MMAM(0, 0, At, B0); PG8_MMAM(0, 1, At, B1); PG8_BAR; PG8_SCHED;
            PG8_LDA(At, 0, 1); PG8_STAGE(PG8_SB(0, 0), b2, voffB); PG8_STAGE(PG8_SB(0, 1), b2 + hstepB, voffB); PG8_STAGE(PG8_SA(0, 0), a2, voffA);
            PG8_WAIT_V(8); PG8_WAIT_L(0); PG8_BAR; PG8_MMAM(1, 0, At, B0); PG8_MMAM(1, 1, At, B1); PG8_BAR; PG8_SCHED;
            PG8_LDB(B0, 1, 0); PG8_LDB(B1, 1, 1); PG8_SCHED; PG8_LDA(At, 1, 0); PG8_STAGE(PG8_SA(0, 1), a2 + hstepA, voffA);
            PG8_WAIT_V(8); PG8_WAIT_L(0); PG8_BAR; PG8_MMAM(0, 0, At, B0); PG8_MMAM(0, 1, At, B1); PG8_BAR; PG8_SCHED;
            PG8_LDA(At, 1, 1); PG8_STAGE(PG8_SB(1, 0), b3, voffB); PG8_STAGE(PG8_SB(1, 1), b3 + hstepB, voffB); PG8_STAGE(PG8_SA(1, 0), a3, voffA);
            PG8_WAIT_V(8); PG8_WAIT_L(0); PG8_BAR; PG8_MMAM(1, 0, At, B0); PG8_MMAM(1, 1, At, B1); PG8_BAR; PG8_SCHED;
            } else {
            PG8_LDB(B0, 0, 0); PG8_SCHED; PG8_LDA(At, 0, 0); PG8_STAGE(PG8_SA(1, 1), a1 + hstepA, voffA);
            PG8_WAIT_L(8); PG8_BAR; PG8_WAIT_L(0); PG8_MMA(0, 0, At, B0); PG8_BAR; PG8_SCHED;
            PG8_LDB(B1, 0, 1); PG8_STAGE(PG8_SB(0, 0), b2, voffB);
            PG8_BAR; PG8_WAIT_L(0); PG8_MMA(0, 1, At, B1); PG8_BAR;
            PG8_LDA(At, 0, 1); PG8_STAGE(PG8_SA(0, 0), a2, voffA);
            PG8_BAR; PG8_WAIT_L(0); PG8_MMA(1, 0, At, B0); PG8_BAR; PG8_SCHED;
            PG8_STAGE(PG8_SB(0, 1), b2 + hstepB, voffB);
            PG8_WAIT_V(6); PG8_BAR; PG8_MMA(1, 1, At, B1); PG8_BAR;
            PG8_LDB(B0, 1, 0); PG8_SCHED; PG8_LDA(At, 1, 0); PG8_STAGE(PG8_SA(0, 1), a2 + hstepA, voffA);
            PG8_WAIT_L(8); PG8_BAR; PG8_WAIT_L(0); PG8_MMA(0, 0, At, B0); PG8_BAR; PG8_SCHED;
            PG8_LDB(B1, 1, 1); PG8_STAGE(PG8_SB(1, 0), b3, voffB);
            PG8_BAR; PG8_WAIT_L(0); PG8_MMA(0, 1, At, B1); PG8_BAR;
            PG8_LDA(At, 1, 1); PG8_STAGE(PG8_SA(1, 0), a3, voffA);
            PG8_BAR; PG8_WAIT_L(0); PG8_MMA(1, 0, At, B0); PG8_BAR; PG8_SCHED;
            PG8_STAGE(PG8_SB(1, 1), b3 + hstepB, voffB);
            PG8_WAIT_V(6); PG8_BAR; PG8_MMA(1, 1, At, B1); PG8_BAR;
            }
        }
        if constexpr (ALIGN_EPI) { if (wr == 0) PG8_BAR; }
        E(acc, cur, wr, wc, fr, fq); S.done(cur);
        if (!has_next) break;
#pragma unroll
        for (int a = 0; a < 2; ++a)
#pragma unroll
            for (int b = 0; b < 2; ++b)
#pragma unroll
                for (int m = 0; m < 4; ++m)
#pragma unroll
                    for (int n = 0; n < 2; ++n) acc[a][b][m][n] = (f32x4){0.f, 0.f, 0.f, 0.f};
        cur = nxt; cA = nA; cB = nB; ++ui;
        if constexpr (ALIGN_EPI) { if (wr == 1) PG8_BAR; }
    }
    PG8_WAIT_V(0);
    if constexpr (!ALIGN_EPI) { if (wr == 0) PG8_BAR; }
    PG8_BAR;
#undef PG8_AT
#undef PG8_SA
#undef PG8_SB
#undef PG8_STAGE
#undef PG8_LDA
#undef PG8_LDB
#undef PG8_MMA
#undef PG8_MMAM
#undef PG8_WAIT_V
#undef PG8_WAIT_L
#undef PG8_BAR
#undef PG8_SCHED
}
}

constexpr int NB = 8, SEQ = 4096, D = 1024, T = NB * SEQ, MEML = 256, MT = NB * MEML, FF = 4096, DEPTH = 2;
constexpr int INW = 6840, ZW = 2816;
constexpr float EPS = 1e-6f;
constexpr int Z_CQ = 0, Z_CKV = 256, Z_KPE = 384, Z_GLR = 416, Z_DA = 432, Z_DB = 436, Z_SGU = 512, Z_SGV = 768, Z_GQ = 1024, Z_GK = 1152, Z_GV = 1280, Z_GOG = 1536, Z_DQ = 1792, Z_DZ = 2560;

constexpr size_t MiB = 1u << 20;
constexpr size_t WS_CTL = 0, CTL_ZERO_BYTES = 1 * MiB;
constexpr size_t WS_ROPEC = 1 * MiB, WS_ROPES = 3 * MiB;
constexpr size_t WS_KX = 5 * MiB, WS_VX = 9 * MiB, WS_MEMN = 13 * MiB;
constexpr size_t WS_WZ = 17 * MiB;
constexpr size_t WS_WMLA = WS_WZ + 5 * MiB + MiB / 2;
constexpr size_t WS_WMRG = WS_WMLA + 1 * MiB;
constexpr size_t WS_WOUT = WS_WMRG + 16 * MiB;
constexpr size_t WS_WXQ = WS_WOUT + 2 * MiB, WS_WXK = WS_WXQ + 2 * MiB, WS_WXV = WS_WXK + 2 * MiB, WS_WXO = WS_WXV + 2 * MiB;
constexpr size_t WS_WUP = WS_WXO + 2 * MiB;
constexpr size_t WS_WDN = WS_WUP + 8 * MiB;
static_assert(WS_WDN + 8 * MiB <= 66 * MiB, "weights");
constexpr size_t WS_HB = 66 * MiB;
constexpr size_t WS_BR = 130 * MiB;
constexpr size_t WS_ZA = 194 * MiB;
constexpr size_t WS_ZB = 258 * MiB;
constexpr size_t WS_Q = 370 * MiB, WS_K = WS_Q + 24 * MiB, WS_V = WS_K + 24 * MiB;
constexpr size_t WS_XC = 194 * MiB, WS_WT = 210 * MiB, WS_KDT = 226 * MiB, WS_QD = 242 * MiB;
constexpr size_t WS_AT = 434 * MiB, WS_BS = 450 * MiB, WS_EG = 466 * MiB, WS_GL = 466 * MiB + 512 * 1024, WS_SNT = 467 * MiB;
constexpr size_t WS_PJ = 194 * MiB;
constexpr size_t WS_MG = 130 * MiB, WS_XQ = 258 * MiB, WS_XO = 322 * MiB;
constexpr size_t WS_HID = 130 * MiB;
constexpr size_t WS_ZF = 498 * MiB;
constexpr size_t WS_SSQ = 502 * MiB;
constexpr size_t WS_WSM = 503 * MiB;
constexpr size_t WS_SS16 = 504 * MiB;
constexpr size_t WS_SS16B = 506 * MiB;
constexpr size_t WS_R1 = 508 * MiB;
constexpr size_t WS_END = 509 * MiB;

constexpr int CW_TMO = 0, CW_CODE = 1, CW_BAR = 4096, CW_Q = 8192;

constexpr int RING_OFF = 0, G1_OFF = 139264, RING_BYTES = 139264 + 4 * 4096;
constexpr int LDSCTL_OFF = RING_BYTES, MISC_OFF = LDSCTL_OFF + 320;
constexpr int LDS_BYTES = 163840;

#define GAS __attribute__((address_space(1)))
#define LAS __attribute__((address_space(3)))
typedef unsigned short bf16;
typedef unsigned v4u __attribute__((ext_vector_type(4)));
typedef unsigned v2u __attribute__((ext_vector_type(2)));
typedef float f32x4 __attribute__((ext_vector_type(4)));
typedef GAS unsigned gu32;
#define RLX_AGENT __ATOMIC_RELAXED, __HIP_MEMORY_SCOPE_AGENT
#define LDS_WAIT() asm volatile("s_waitcnt lgkmcnt(0)" ::: "memory")
#define VM_WAIT() asm volatile("s_waitcnt vmcnt(0)" ::: "memory")
__device__ __forceinline__ unsigned f2bf(float f) { unsigned u = __builtin_bit_cast(unsigned, f); return (u + 0x7fffu + ((u >> 16) & 1u)) >> 16; }
__device__ __forceinline__ unsigned pk2(float lo, float hi) { return f2bf(lo) | (f2bf(hi) << 16); }
__device__ __forceinline__ float bf2f(unsigned short b) { return __uint_as_float(((unsigned)b) << 16); }
__device__ __forceinline__ float bflo(unsigned w) { return __uint_as_float(w << 16); }
__device__ __forceinline__ float bfhi(unsigned w) { return __uint_as_float(w & 0xffff0000u); }

#define XB_TMO      128
#define XB_XCNT(j)  (256  + 64 * (j))
#define XB_XSUB(j)  (1280 + 64 * (j))
#define XB_XGEN(j)  (2304 + 64 * (j))
#define XB_TOP      3328
#define XB_TOPGEN   3392
#define XCD_BAR_WORDS 3456
#define XB_SPIN_CAP (1u << 18)
__device__ __forceinline__ unsigned xb_ld(unsigned* p)              { return __hip_atomic_load(p, __ATOMIC_RELAXED, __HIP_MEMORY_SCOPE_AGENT); }
__device__ __forceinline__ unsigned xb_add(unsigned* p, unsigned v) { return __hip_atomic_fetch_add(p, v, __ATOMIC_RELAXED, __HIP_MEMORY_SCOPE_AGENT); }
__device__ __forceinline__ unsigned xb_xcc_id() { return (unsigned)__builtin_amdgcn_s_getreg((3 << 11) | 20) & 0xFu; }
#define XB_SPIN(cond, bar) do { unsigned _sp = 0; while (cond) { __builtin_amdgcn_s_sleep(1); \
    if ((++_sp & 255u) == 0u) { if (xb_ld(&(bar)[XB_TMO])) break; if (_sp > XB_SPIN_CAP) { atomicAdd(&(bar)[XB_TMO], 1u); break; } } } } while (0)
struct XcdBarrier { unsigned* bar; unsigned x; volatile LAS unsigned* st; };
__device__ __forceinline__ XcdBarrier xcd_barrier_post(unsigned* bar, volatile LAS unsigned* st) {
    XcdBarrier b; b.bar = bar; b.x = xb_xcc_id(); b.st = st;
    if (threadIdx.x == 0) (void)xb_add(&bar[XB_XCNT(b.x)], 1u);
    return b;
}
__device__ __forceinline__ void xcd_barrier_complete(unsigned* bar, unsigned x, unsigned& nloc, unsigned& nx) {
    const unsigned G = gridDim.x * gridDim.y * gridDim.z;
    unsigned sum, cnt, mine, sp = 0u;
    for (;;) {
        sum = 0u; cnt = 0u; mine = 0u;
#pragma unroll
        for (unsigned j = 0; j < 16; ++j) { const unsigned c = xb_ld(&bar[XB_XCNT(j)]); sum += c; cnt += (c > 0u) ? 1u : 0u; mine = (j == x) ? c : mine; }
        if (sum == G) break;
        __builtin_amdgcn_s_sleep(1);
        if ((++sp & 255u) == 0u) { if (xb_ld(&bar[XB_TMO])) break; if (sp > XB_SPIN_CAP) { atomicAdd(&bar[XB_TMO], 1u); break; } }
    }
    nloc = mine > 0u ? mine : 1u; nx = cnt > 0u ? cnt : 1u;
}
__device__ __forceinline__ void xcd_barrier(const XcdBarrier& b) {
    asm volatile("s_waitcnt vmcnt(0)" ::: "memory");
    __syncthreads();
    if (threadIdx.x == 0) {
        unsigned* bar = b.bar;
        __builtin_amdgcn_s_waitcnt(0);
        unsigned nloc = b.st[0], nx = b.st[1];
        if (nloc == 0u) { xcd_barrier_complete(bar, b.x, nloc, nx); b.st[0] = nloc; b.st[1] = nx; }
        const unsigned old = xb_add(&bar[XB_XSUB(b.x)], 1u);
        const unsigned gen = old / nloc;
        if (old + 1u == (gen + 1u) * nloc) {
            __builtin_amdgcn_fence(__ATOMIC_RELEASE, "agent");
            asm volatile("s_waitcnt vmcnt(0)" ::: "memory");
            const unsigned og = xb_add(&bar[XB_TOP], 1u);
            const unsigned tg = og / nx;
            if (og + 1u == (tg + 1u) * nx) xb_add(&bar[XB_TOPGEN], 1u);
            else XB_SPIN(xb_ld(&bar[XB_TOPGEN]) == tg, bar);
            __builtin_amdgcn_fence(__ATOMIC_ACQUIRE, "agent");
            xb_add(&bar[XB_XGEN(b.x)], 1u);
            asm volatile("s_waitcnt vmcnt(0)" ::: "memory");
        } else {
            XB_SPIN(xb_ld(&bar[XB_XGEN(b.x)]) == gen, bar);
            __builtin_amdgcn_fence(__ATOMIC_ACQUIRE, "agent");
            asm volatile("s_waitcnt vmcnt(0)" ::: "memory");
        }
    }
    __syncthreads();
}

constexpr int NWAVES = 8;
struct Frame {
    LAS unsigned char* lds;
    int tid, lane, wave;
    int vcu, G;
};
__device__ __forceinline__ float dpp_row_sum(float v) {
    v += __int_as_float(__builtin_amdgcn_update_dpp(0, __float_as_int(v), 0xB1, 0xF, 0xF, true));
    v += __int_as_float(__builtin_amdgcn_update_dpp(0, __float_as_int(v), 0x4E, 0xF, 0xF, true));
    v += __int_as_float(__builtin_amdgcn_update_dpp(0, __float_as_int(v), 0x141, 0xF, 0xF, true));
    v += __int_as_float(__builtin_amdgcn_update_dpp(0, __float_as_int(v), 0x140, 0xF, 0xF, true));
    return v;
}
__device__ __forceinline__ float wave_sum(float v) { v = dpp_row_sum(v); v += __shfl_xor(v, 16); v += __shfl_xor(v, 32); return v; }
__device__ __forceinline__ float sigmoidf_(float x) { return __builtin_amdgcn_rcpf(1.0f + __expf(-x)); }
__device__ __forceinline__ float gelu_tanh(float x) { const float y = 0.7978845608028654f * (x + 0.044715f * x * x * x); const float t = 1.0f - 2.0f / (1.0f + __expf(2.0f * y)); return 0.5f * x * (1.0f + t); }
__device__ __forceinline__ float log1pexp_neg(float e) { const float a = e * (1.0f - e * (0.5f - e * 0.33333333f)), b = __logf(1.0f + e); const unsigned m = (e < 1e-2f) ? 0xffffffffu : 0u;
    return __uint_as_float((__float_as_uint(a) & m) | (__float_as_uint(b) & ~m)); }
__device__ __forceinline__ float softplusf_(float x) { return fmaxf(x, 0.f) + log1pexp_neg(__expf(-fabsf(x))); }
__device__ __forceinline__ float logsigmoidf_(float x) { return fminf(x, 0.f) - log1pexp_neg(__expf(-fabsf(x))); }

template <class Fn> __device__ __forceinline__ void wprep_tile(const Fn& f, bf16* dst, int ldd, int R0, int k0, LAS float* scr, int lane) {
#pragma unroll 1
    for (int i0 = 0; i0 < 32; i0 += 16) { float tv[16];
#pragma unroll
        for (int i = 0; i < 16; ++i) tv[i] = f(R0 + (lane & 31), k0 + 2 * (i0 + i) + (lane >> 5));
#pragma unroll
        for (int i = 0; i < 16; ++i) scr[(2 * (i0 + i) + (lane >> 5)) * 33 + (lane & 31)] = tv[i]; }
    LDS_WAIT(); asm volatile("" ::: "memory");
    const int c = lane & 7;
#pragma unroll
    for (int j = 0; j < 4; ++j) { const int n = (lane >> 3) + 8 * j; const LAS float* s = scr + (8 * c) * 33 + n;
        v4u o; o.x = pk2(s[0 * 33], s[1 * 33]); o.y = pk2(s[2 * 33], s[3 * 33]); o.z = pk2(s[4 * 33], s[5 * 33]); o.w = pk2(s[6 * 33], s[7 * 33]);
        *(GAS v4u*)(dst + (size_t)(R0 + n) * ldd + k0 + 8 * c) = o; }
    LDS_WAIT(); asm volatile("" ::: "memory");
}
__device__ __forceinline__ int zcol_src(int R) {
    if (R < 416) return R;
    if (R < 432) return 1440 + (R - 416);
    if (R < 436) return 2480 + (R - 432);
    if (R < 440) return 2484 + (R - 436);
    if (R < 512) return -1;
    if (R < 1024) return 416 + (R - 512);
    if (R < 1280) return 928 + (R - 1024);
    if (R < 1536) return 1184 + (R - 1280);
    if (R < 1792) return 1456 + (R - 1536);
    if (R < 2560) return 1712 + (R - 1792);
    return 2488 + (R - 2560);
}
struct FnWz { const float* win; const float* gain; __device__ __forceinline__ float operator()(int R, int k) const { const int c = zcol_src(R); const float w = gain[k] * win[(size_t)k * INW + (c < 0 ? 0 : c)]; return c < 0 ? 0.f : w; } };
struct FnZero { __device__ __forceinline__ float operator()(int, int) const { return 0.f; } };
struct FnWuq { const float* wuq; const float* nq;
    __device__ __forceinline__ float operator()(int R, int k) const { const int h = R / 96, o = R - 96 * h, jj = o - 64; const int sc = h * 96 + (o < 64 ? o : 64 + (jj & 1) * 16 + (jj >> 1)); return nq[k] * wuq[k * 384 + sc]; } };
struct FnWukv { const float* wukv; const float* nkv;
    __device__ __forceinline__ float operator()(int R, int k) const { return nkv[k - 256] * wukv[(k - 256) * 512 + (R - 384)]; } };
struct FnIdent { __device__ __forceinline__ float operator()(int R, int k) const { const int jj = R - 896; return (k == 384 + (jj & 1) * 16 + (jj >> 1)) ? 1.0f : 0.f; } };
struct FnWmrg { const float* win; const float* gain;
    __device__ __forceinline__ float operator()(int R, int k) const {
        const int pn = R >> 8, c = R & 255, bj = c >> 7, wc = (c >> 5) & 3, n = (c >> 4) & 1, fq = (c >> 2) & 3, e = c & 3;
        const int gate = 2 * bj + n, d = 64 * pn + 16 * wc + 4 * fq + e;
        return gain[k] * win[(size_t)k * INW + 2744 + gate * 1024 + d]; } };
template <bool GAIN> struct FnT { const float* W; int N; const float* gain; __device__ __forceinline__ float operator()(int R, int k) const { const float w = W[(size_t)k * N + R]; if constexpr (GAIN) return gain[k] * w; else return w; } };

__device__ __forceinline__ void rms_row_bf16(const float* xrow, const float* gain, bf16* orow, int lane) {
    const GAS f32x4* xr = (const GAS f32x4*)xrow + lane; const GAS f32x4* gr = (const GAS f32x4*)gain + lane;
    f32x4 v[4]; float s = 0.f;
#pragma unroll
    for (int j = 0; j < 4; ++j) { v[j] = xr[64 * j]; s += (v[j].x * v[j].x + v[j].y * v[j].y) + (v[j].z * v[j].z + v[j].w * v[j].w); }
    const float r = 1.0f / sqrtf(wave_sum(s) * (1.f / 1024.f) + EPS);
    GAS unsigned long long* o8 = (GAS unsigned long long*)orow + lane;
#pragma unroll
    for (int j = 0; j < 4; ++j) { const f32x4 gg = gr[64 * j]; o8[64 * j] = (unsigned long long)pk2(v[j].x * r * gg.x, v[j].y * r * gg.y) | ((unsigned long long)pk2(v[j].z * r * gg.z, v[j].w * r * gg.w) << 32); }
}
__device__ __forceinline__ void rope_entry(int pos, int j, float& c, float& s) {
    const int q4 = j >> 2, r4 = j & 3;
    float ff = (r4 == 0) ? 1.0f : (r4 == 1) ? 0.5623413251903491f : (r4 == 2) ? 0.31622776601683794f : 0.17782794100389228f;
    ff *= (q4 == 0) ? 1.0f : (q4 == 1) ? 0.1f : (q4 == 2) ? 0.01f : 0.001f;
    const double ang = (double)pos * (double)ff;
    const double kq = __builtin_rint(ang * 0.6366197723675814);
    const float r = (float)(ang - kq * 1.5707963267948966), r2 = r * r;
    const float sn = r + r * r2 * (-1.0f / 6 + r2 * (1.0f / 120 + r2 * (-1.0f / 5040 + r2 * (1.0f / 362880))));
    const float cs = 1.0f + r2 * (-0.5f + r2 * (1.0f / 24 + r2 * (-1.0f / 720 + r2 * (1.0f / 40320 + r2 * (-1.0f / 3628800)))));
    const int q = ((int)kq) & 3;
    s = (q == 0) ? sn : (q == 1) ? cs : (q == 2) ? -sn : -cs;
    c = (q == 0) ? cs : (q == 1) ? -sn : (q == 2) ? -cs : sn;
}


typedef float f32x16 __attribute__((ext_vector_type(16)));
typedef short bf16x8v __attribute__((ext_vector_type(8)));
__device__ __forceinline__ float rdlane(float v, int l) { return __int_as_float(__builtin_amdgcn_readlane(__float_as_int(v), l)); }
__device__ __forceinline__ unsigned pkbf(float lo, float hi) { return pg8::cvt_pk_bf16(lo, hi); }
using pg8::row_rscale;
constexpr int ZBW = 1792;
constexpr int ZB_GQ = 0, ZB_GK = 128, ZB_GV = 256, ZB_GOG = 512, ZB_DQ = 768, ZB_DK = 1024, ZB_DV = 1280, ZB_DZ = 1536;
constexpr int XKS = 68;

__device__ __forceinline__ void gla1_item(int item, int lane, bf16* ZBp, const float* ZFp, const float* wg, const float* bg, float* BS, float* EG) {
    asm volatile("" : "+v"(lane));
    const int chunk = item >> 2, h = item & 3, kap = lane & 31, half = lane >> 5; const size_t t0 = (size_t)chunk * 64;
    char* zrow = (char*)(ZBp + t0 * ZBW + h * 32); const unsigned loff = (unsigned)((32 * half * ZBW + kap) * 2);
    const char* frow = (const char*)(ZFp + t0 * 32); const unsigned foff = (unsigned)(32 * half * 32 * 4);
    float w[16];
#pragma unroll
    for (int r = 0; r < 16; ++r) w[r] = wg[r * 128 + h * 32 + kap];
    const float bb = bg[h * 32 + kap];
    float ls[32]; float tot = 0.f;
#pragma unroll
    for (int jj = 0; jj < 32; ++jj) { const char* zf = frow + (size_t)(jj * 32 * 4) + foff; float pre = bb;
        const f32x4 z0 = *(const f32x4*)zf, z1 = *(const f32x4*)(zf + 16), z2 = *(const f32x4*)(zf + 32), z3 = *(const f32x4*)(zf + 48);
        pre += z0[0] * w[0] + z0[1] * w[1] + z0[2] * w[2] + z0[3] * w[3] + z1[0] * w[4] + z1[1] * w[5] + z1[2] * w[6] + z1[3] * w[7]
             + z2[0] * w[8] + z2[1] * w[9] + z2[2] * w[10] + z2[3] * w[11] + z3[0] * w[12] + z3[1] * w[13] + z3[2] * w[14] + z3[3] * w[15];
        ls[jj] = logsigmoidf_(pre) * (1.0f / 16.0f); tot += ls[jj]; }
    asm volatile("" ::: "memory");
    unsigned short kr[32], qr[32];
#pragma unroll
    for (int jj = 0; jj < 32; ++jj) { kr[jj] = *(const bf16*)(zrow + (size_t)(jj * ZBW + ZB_GK) * 2 + loff); qr[jj] = *(const bf16*)(zrow + (size_t)(jj * ZBW + ZB_GQ) * 2 + loff); }
    unsigned short vr[2][32];
#pragma unroll
    for (int jj = 0; jj < 32; ++jj) { const char* vp = zrow + (size_t)(jj * ZBW + ZB_GV + h * 32) * 2 + loff; vr[0][jj] = *(const bf16*)vp; vr[1][jj] = *(const bf16*)(vp + 64); }
    const float other = __shfl_xor(tot, 32); float cum = half ? other : 0.f;
    unsigned ka[16];
#pragma unroll
    for (int jj = 0; jj < 32; ++jj) { cum += ls[jj];
        const unsigned k16v = f2bf(bf2f(kr[jj]) * __expf(-cum)), q16v = f2bf(bf2f(qr[jj]) * 0.17677669529663687f * __expf(cum));
        *(bf16*)(zrow + (size_t)(jj * ZBW + ZB_GK) * 2 + loff) = (bf16)k16v; *(bf16*)(zrow + (size_t)(jj * ZBW + ZB_GQ) * 2 + loff) = (bf16)q16v;
        if (jj & 1) ka[jj >> 1] |= k16v << 16; else ka[jj >> 1] = k16v; }
    tot += other;
    char* bsrow = (char*)(BS + (size_t)item * 2048); const unsigned boff = (unsigned)((4 * half * 64 + kap) * 4);
#pragma unroll
    for (int nb = 0; nb < 2; ++nb) { f32x16 acc;
#pragma unroll
        for (int r = 0; r < 16; ++r) acc[r] = 0.f;
#pragma unroll
        for (int st = 0; st < 4; ++st) { v4u av, bv; av.x = ka[4 * st]; av.y = ka[4 * st + 1]; av.z = ka[4 * st + 2]; av.w = ka[4 * st + 3];
            bv.x = (unsigned)vr[nb][8 * st] | ((unsigned)vr[nb][8 * st + 1] << 16); bv.y = (unsigned)vr[nb][8 * st + 2] | ((unsigned)vr[nb][8 * st + 3] << 16);
            bv.z = (unsigned)vr[nb][8 * st + 4] | ((unsigned)vr[nb][8 * st + 5] << 16); bv.w = (unsigned)vr[nb][8 * st + 6] | ((unsigned)vr[nb][8 * st + 7] << 16);
            acc = __builtin_amdgcn_mfma_f32_32x32x16_bf16(__builtin_bit_cast(bf16x8v, av), __builtin_bit_cast(bf16x8v, bv), acc, 0, 0, 0); }
#pragma unroll
        for (int r = 0; r < 16; ++r) *(float*)(bsrow + (size_t)((((r & 3) + 8 * (r >> 2)) * 64 + 32 * nb) * 4) + boff) = acc[r]; }
    if (half == 0) EG[item * 32 + kap] = __expf(tot);
}
template <bool XS> __device__ __forceinline__ void dn1_solve(LAS float* Tl, const LAS float* Lm, int c, float beta, float gam, bf16* XCp) {
#pragma unroll 1
    for (int b = 0; b < 4; ++b) { float acc[16];
        { float t16[16];
#pragma unroll
          for (int r = 0; r < 16; ++r) t16[r] = Tl[(16 * b + r) * XKS + c];
          __builtin_amdgcn_sched_barrier(0);
#pragma unroll
          for (int r = 0; r < 16; ++r) { const int i = 16 * b + r; float sc = rdlane(beta, i); if (XS) sc *= __expf(rdlane(gam, i)); acc[r] = sc * t16[r]; } }
        for (int jb = 0; jb < b; ++jb) {
#pragma unroll 1
            for (int jq = 0; jq < 4; ++jq) { const LAS float* xp = Tl + (16 * jb + 4 * jq) * XKS + c; const float x0 = xp[0], x1 = xp[XKS], x2 = xp[2 * XKS], x3 = xp[3 * XKS];
                f32x4 l[16];
#pragma unroll
                for (int r = 0; r < 16; ++r) l[r] = *(const LAS f32x4*)(Lm + (16 * b + r) * XKS + 16 * jb + 4 * jq);
                __builtin_amdgcn_sched_barrier(0);
#pragma unroll
                for (int r = 0; r < 16; ++r) acc[r] -= (l[r][0] * x0 + l[r][1] * x1) + (l[r][2] * x2 + l[r][3] * x3); } }
        float xs[16];
        xs[0] = acc[0];
#pragma unroll
        for (int g4 = 0; g4 < 4; ++g4) {
            f32x4 ld[4][4];
#pragma unroll
            for (int rr = 0; rr < 4; ++rr)
#pragma unroll
                for (int q = 0; q < 4; ++q) if (4 * q < 4 * g4 + rr) ld[rr][q] = *(const LAS f32x4*)(Lm + (16 * b + 4 * g4 + rr) * XKS + 16 * b + 4 * q);
            __builtin_amdgcn_sched_barrier(0);
#pragma unroll
            for (int rr = 0; rr < 4; ++rr) { const int r = 4 * g4 + rr; if (r == 0) continue; float v = acc[r];
#pragma unroll
                for (int q = 0; q < 4; ++q) if (4 * q < r) {
#pragma unroll
                    for (int e = 0; e < 4; ++e) if (4 * q + e < r) v -= ld[rr][q][e] * xs[4 * q + e]; }
                xs[r] = v; } }
#pragma unroll
        for (int r = 0; r < 16; ++r) { Tl[(16 * b + r) * XKS + c] = xs[r]; if (XS) XCp[(16 * b + r) * 64] = (bf16)f2bf(xs[r]); } }
}
__device__ __forceinline__ void dn1_item(int item, int lane, LAS float* Xk, LAS float* Lm, const bf16* ZBp, const float* ZFp, const float* cw, float Aexp, float dtb,
                                         bf16* XC, bf16* WT, bf16* KDT, bf16* QD, bf16* AT, float* GL) {
    asm volatile("" : "+v"(lane));
    const int chunk = item >> 2, h = item & 3; const size_t t0 = (size_t)chunk * 64; const int s0 = (int)(t0 & (SEQ - 1));
    const size_t t = t0 + lane; const size_t ib = (size_t)item * 4096; const int c = lane;
    { const float* wq = cw + h * 64 + lane; const float* wk = cw + 256 + h * 64 + lane;
      const float q0w = wq[0], q1w = wq[768], q2w = wq[2 * 768], q3w = wq[3 * 768], k0w = wk[0], k1w = wk[768], k2w = wk[2 * 768], k3w = wk[3 * 768];
      const bf16* qcol = ZBp + t0 * ZBW + ZB_DQ + h * 64 + lane; const bf16* kcol = qcol + 256;
      float xq0 = 0.f, xq1 = 0.f, xq2 = 0.f, xk0 = 0.f, xk1 = 0.f, xk2 = 0.f;
      if (s0 > 0) { xq0 = bf2f(*(qcol - 3 * ZBW)); xq1 = bf2f(*(qcol - 2 * ZBW)); xq2 = bf2f(*(qcol - ZBW)); xk0 = bf2f(*(kcol - 3 * ZBW)); xk1 = bf2f(*(kcol - 2 * ZBW)); xk2 = bf2f(*(kcol - ZBW)); }
#pragma unroll 1
      for (int ih = 0; ih < 64; ih += 32) { unsigned short rq[32], rk[32];
#pragma unroll
          for (int i = 0; i < 32; ++i) { rq[i] = qcol[(size_t)(ih + i) * ZBW]; rk[i] = kcol[(size_t)(ih + i) * ZBW]; }
#pragma unroll
          for (int i = 0; i < 32; ++i) { const float x3 = bf2f(rq[i]); const float a = q0w * xq0 + q1w * xq1 + q2w * xq2 + q3w * x3; Lm[(ih + i) * XKS + lane] = a * sigmoidf_(a); xq0 = xq1; xq1 = xq2; xq2 = x3;
              const float y3 = bf2f(rk[i]); const float bq = k0w * xk0 + k1w * xk1 + k2w * xk2 + k3w * y3; Xk[(ih + i) * XKS + lane] = bq * sigmoidf_(bq); xk0 = xk1; xk1 = xk2; xk2 = y3; } } }
    LDS_WAIT(); asm volatile("" ::: "memory");
    { float ssq = 0.f;
#pragma unroll 4
      for (int d4 = 0; d4 < 16; ++d4) { const f32x4 r4 = *(const LAS f32x4*)(Xk + lane * XKS + 4 * d4); ssq += (r4[0] * r4[0] + r4[1] * r4[1]) + (r4[2] * r4[2] + r4[3] * r4[3]); }
      const float rn = 1.0f / sqrtf(ssq + EPS);
#pragma unroll 4
      for (int d4 = 0; d4 < 16; ++d4) { const f32x4 r4 = *(const LAS f32x4*)(Xk + lane * XKS + 4 * d4); *(LAS f32x4*)(Xk + lane * XKS + 4 * d4) = r4 * rn; } }
    asm volatile("" ::: "memory");
    { float ssq = 0.f;
#pragma unroll 4
      for (int d4 = 0; d4 < 16; ++d4) { const f32x4 r4 = *(const LAS f32x4*)(Lm + lane * XKS + 4 * d4); ssq += (r4[0] * r4[0] + r4[1] * r4[1]) + (r4[2] * r4[2] + r4[3] * r4[3]); }
      const float rn = 0.125f / sqrtf(ssq + EPS);
#pragma unroll 4
      for (int d4 = 0; d4 < 16; ++d4) { const f32x4 r4 = *(const LAS f32x4*)(Lm + lane * XKS + 4 * d4); *(LAS f32x4*)(Lm + lane * XKS + 4 * d4) = r4 * rn; } }
    const float beta = sigmoidf_(ZFp[t * 32 + 20 + h]);
    float gam = -Aexp * softplusf_(ZFp[t * 32 + 16 + h] + dtb);
#pragma unroll
    for (int o = 1; o < 64; o <<= 1) { const float tmp = __shfl_up(gam, o); if (lane >= o) gam += tmp; }
    const float glast = rdlane(gam, 63);
    Xk[lane * XKS + 64] = gam; Xk[lane * XKS + 65] = beta;
    LDS_WAIT(); asm volatile("" ::: "memory");
    const int cc = lane & 31, hh = lane >> 5;
#pragma unroll 1
    for (int tIJ = 0; tIJ < 4; ++tIJ) { const int tI = tIJ >> 1, tJ = tIJ & 1; f32x16 acc;
#pragma unroll
            for (int r = 0; r < 16; ++r) acc[r] = 0.f;
            if (tI >= tJ) {
                f32x4 a4[8], b4[8];
#pragma unroll
                for (int u = 0; u < 8; ++u) { a4[u] = *(const LAS f32x4*)(Lm + (32 * tI + cc) * XKS + 32 * hh + 4 * u); b4[u] = *(const LAS f32x4*)(Xk + (32 * tJ + cc) * XKS + 32 * hh + 4 * u); }
                __builtin_amdgcn_sched_barrier(0);
#pragma unroll
                for (int u = 0; u < 8; ++u)
#pragma unroll
                    for (int e = 0; e < 4; ++e) acc = __builtin_amdgcn_mfma_f32_32x32x2f32(a4[u][e], b4[u][e], acc, 0, 0, 0); }
            const int j = 32 * tJ + cc; const float gj = Xk[j * XKS + 64]; bf16* atp = AT + ib + j;
            float gi[16];
#pragma unroll
            for (int r = 0; r < 16; ++r) gi[r] = Xk[(32 * tI + (r & 3) + 8 * (r >> 2) + 4 * hh) * XKS + 64];
            __builtin_amdgcn_sched_barrier(0);
#pragma unroll
            for (int r = 0; r < 16; ++r) { const int i = 32 * tI + (r & 3) + 8 * (r >> 2) + 4 * hh; const float val = acc[r] * __expf(fminf(gi[r] - gj, 0.f));
                atp[i * 64] = (bf16)f2bf((j <= i) ? val : 0.f); } }
    { const float eg = __expf(gam); int ln = lane; asm volatile("" : "+v"(ln)); bf16* qdp = QD + ib + ln * 64;
#pragma unroll 2
      for (int d8 = 0; d8 < 8; ++d8) { const f32x4 p0 = *(const LAS f32x4*)(Lm + ln * XKS + 8 * d8) * eg, p1 = *(const LAS f32x4*)(Lm + ln * XKS + 8 * d8 + 4) * eg;
          v4u w; w.x = pkbf(p0[0], p0[1]); w.y = pkbf(p0[2], p0[3]); w.z = pkbf(p1[0], p1[1]); w.w = pkbf(p1[2], p1[3]); *(v4u*)(qdp + 8 * d8) = w; } }
    { const float ek = __expf(glast - gam); int ln = lane; asm volatile("" : "+v"(ln)); bf16* kdp = KDT + ib + ln;
#pragma unroll 2
      for (int d4 = 0; d4 < 16; ++d4) { const f32x4 r4 = *(const LAS f32x4*)(Xk + ln * XKS + 4 * d4) * ek;
          kdp[(4 * d4) * 64] = (bf16)f2bf(r4[0]); kdp[(4 * d4 + 1) * 64] = (bf16)f2bf(r4[1]); kdp[(4 * d4 + 2) * 64] = (bf16)f2bf(r4[2]); kdp[(4 * d4 + 3) * 64] = (bf16)f2bf(r4[3]); } }
    LDS_WAIT(); asm volatile("" ::: "memory");
#pragma unroll 1
    for (int tIJ = 0; tIJ < 4; ++tIJ) { const int tI = tIJ >> 1, tJ = tIJ & 1; f32x16 acc;
#pragma unroll
            for (int r = 0; r < 16; ++r) acc[r] = 0.f;
            if (tI >= tJ) {
                f32x4 a4[8], b4[8];
#pragma unroll
                for (int u = 0; u < 8; ++u) { a4[u] = *(const LAS f32x4*)(Xk + (32 * tI + cc) * XKS + 32 * hh + 4 * u); b4[u] = *(const LAS f32x4*)(Xk + (32 * tJ + cc) * XKS + 32 * hh + 4 * u); }
                __builtin_amdgcn_sched_barrier(0);
#pragma unroll
                for (int u = 0; u < 8; ++u)
#pragma unroll
                    for (int e = 0; e < 4; ++e) acc = __builtin_amdgcn_mfma_f32_32x32x2f32(a4[u][e], b4[u][e], acc, 0, 0, 0); }
            const int j = 32 * tJ + cc; const float gj = Xk[j * XKS + 64];
            float gi[16], bi[16];
#pragma unroll
            for (int r = 0; r < 16; ++r) { const LAS float* gp = Xk + (32 * tI + (r & 3) + 8 * (r >> 2) + 4 * hh) * XKS + 64; gi[r] = gp[0]; bi[r] = gp[1]; }
            __builtin_amdgcn_sched_barrier(0);
#pragma unroll
            for (int r = 0; r < 16; ++r) { const int i = 32 * tI + (r & 3) + 8 * (r >> 2) + 4 * hh; const float val = bi[r] * acc[r] * __expf(fminf(gi[r] - gj, 0.f));
                Lm[i * XKS + j] = (j < i) ? val : 0.f; } }
    LDS_WAIT(); asm volatile("" ::: "memory");
    { int ln = lane; asm volatile("" : "+v"(ln)); dn1_solve<true>(Xk, Lm, c, beta, gam, XC + ib + ln); }
    LDS_WAIT(); asm volatile("" ::: "memory");
    { int ln = lane; asm volatile("" : "+v"(ln)); const float* wvv = cw + 512 + h * 64 + ln; const float w0 = wvv[0], w1 = wvv[768], w2 = wvv[2 * 768], w3 = wvv[3 * 768];
      const bf16* vcol = ZBp + t0 * ZBW + ZB_DV + h * 64 + ln;
      float x0 = 0.f, x1 = 0.f, x2 = 0.f;
      if (s0 > 0) { x0 = bf2f(*(vcol - 3 * ZBW)); x1 = bf2f(*(vcol - 2 * ZBW)); x2 = bf2f(*(vcol - ZBW)); }
#pragma unroll 1
      for (int ih = 0; ih < 64; ih += 32) { unsigned short raw[32];
#pragma unroll
          for (int i = 0; i < 32; ++i) raw[i] = vcol[(size_t)(ih + i) * ZBW];
#pragma unroll
          for (int i = 0; i < 32; ++i) { const float x3 = bf2f(raw[i]); const float a = w0 * x0 + w1 * x1 + w2 * x2 + w3 * x3; Xk[(ih + i) * XKS + c] = a * sigmoidf_(a); x0 = x1; x1 = x2; x2 = x3; } } }
    LDS_WAIT(); asm volatile("" ::: "memory");
    dn1_solve<false>(Xk, Lm, c, beta, gam, nullptr);
    LDS_WAIT(); asm volatile("" ::: "memory");
#pragma unroll 2
    for (int i8 = 0; i8 < 8; ++i8) { const LAS float* xp = Xk + (8 * i8) * XKS + c; v4u w; w.x = pkbf(xp[0], xp[XKS]); w.y = pkbf(xp[2 * XKS], xp[3 * XKS]); w.z = pkbf(xp[4 * XKS], xp[5 * XKS]); w.w = pkbf(xp[6 * XKS], xp[7 * XKS]);
        { int ln = lane; asm volatile("" : "+v"(ln)); *(v4u*)(WT + ib + ln * 64 + 8 * i8) = w; } }
    if (lane == 0) GL[item] = __expf(glast);
    LDS_WAIT(); asm volatile("" ::: "memory");
}
__device__ __forceinline__ bf16x8v ld_frag2x(const bf16* p16, int hh) { const v4u w = *(const v4u*)p16; const unsigned tx = hh ? w.x : w.z, ty = hh ? w.y : w.w;
    const unsigned rx = (unsigned)__shfl_xor((int)tx, 32), ry = (unsigned)__shfl_xor((int)ty, 32); v4u o; if (hh) { o.x = rx; o.y = ry; o.z = w.z; o.w = w.w; } else { o.x = w.x; o.y = w.y; o.z = rx; o.w = ry; } return __builtin_bit_cast(bf16x8v, o); }
__device__ __forceinline__ bf16x8v pack8(const f32x16& x, int s, float sgn) { v4u w; w.x = pkbf(sgn * x[8 * s], sgn * x[8 * s + 1]); w.y = pkbf(sgn * x[8 * s + 2], sgn * x[8 * s + 3]); w.z = pkbf(sgn * x[8 * s + 4], sgn * x[8 * s + 5]); w.w = pkbf(sgn * x[8 * s + 6], sgn * x[8 * s + 7]); return __builtin_bit_cast(bf16x8v, w); }
__device__ __forceinline__ void dn2_worker(int bh, int Jb, int lane, const bf16* XC, bf16* WT, const bf16* KDT, bf16* SNT, const float* GL) {
    const int b = bh >> 2, h = bh & 3, c = lane & 31, hh = lane >> 5;
    f32x16 S0, S1;
#pragma unroll
    for (int r = 0; r < 16; ++r) { S0[r] = 0.f; S1[r] = 0.f; }
    bf16x8v xn[2][2][2]; v2u wn0[4], wn1[4];
#define DN2_LOADX(n_) do { const size_t ib_ = ((size_t)((b * 64 + (n_)) * 4 + h)) * 4096; \
        _Pragma("unroll") for (int I = 0; I < 2; ++I) _Pragma("unroll") for (int K2 = 0; K2 < 2; ++K2) _Pragma("unroll") for (int s2 = 0; s2 < 2; ++s2) xn[I][K2][s2] = ld_frag2x(XC + ib_ + (32 * I + c) * 64 + 32 * K2 + 16 * s2 + 8 * hh, hh); \
        const bf16* wr_ = WT + ib_ + (32 * Jb + c) * 64 + 4 * hh; _Pragma("unroll") for (int g = 0; g < 4; ++g) { wn0[g] = *(const v2u*)(wr_ + 8 * g); wn1[g] = *(const v2u*)(wr_ + 32 + 8 * g); } } while (0)
    DN2_LOADX(0);
    for (int n = 0; n < 64; ++n) {
        const size_t ib = ((size_t)((b * 64 + n) * 4 + h)) * 4096;
        const float gl = GL[(b * 64 + n) * 4 + h];
        bf16x8v xa[2][2][2], ka[2][2][2]; f32x16 u0, u1;
#pragma unroll
        for (int I = 0; I < 2; ++I)
#pragma unroll
            for (int K2 = 0; K2 < 2; ++K2)
#pragma unroll
                for (int s2 = 0; s2 < 2; ++s2) { xa[I][K2][s2] = xn[I][K2][s2]; ka[K2][I][s2] = ld_frag2x(KDT + ib + (32 * K2 + c) * 64 + 32 * I + 16 * s2 + 8 * hh, hh); }
#pragma unroll
        for (int g = 0; g < 4; ++g) { const v2u a = wn0[g], bq = wn1[g];
            u0[4 * g] = bflo(a.x); u0[4 * g + 1] = bfhi(a.x); u0[4 * g + 2] = bflo(a.y); u0[4 * g + 3] = bfhi(a.y);
            u1[4 * g] = bflo(bq.x); u1[4 * g + 1] = bfhi(bq.x); u1[4 * g + 2] = bflo(bq.y); u1[4 * g + 3] = bfhi(bq.y); }
        if (n + 1 < 64) DN2_LOADX(n + 1);
        bf16* wrow = WT + ib + (32 * Jb + c) * 64 + 4 * hh;
        bf16* srow = SNT + ib + (32 * Jb + c) * 64 + 4 * hh;
#pragma unroll
        for (int g = 0; g < 4; ++g) { v2u a, bq; a.x = pkbf(S0[4 * g], S0[4 * g + 1]); a.y = pkbf(S0[4 * g + 2], S0[4 * g + 3]); bq.x = pkbf(S1[4 * g], S1[4 * g + 1]); bq.y = pkbf(S1[4 * g + 2], S1[4 * g + 3]);
            *(v2u*)(srow + 8 * g) = a; *(v2u*)(srow + 32 + 8 * g) = bq; }
#pragma unroll
        for (int s2 = 0; s2 < 2; ++s2) { const bf16x8v b0 = pack8(S0, s2, -1.f), b1 = pack8(S1, s2, -1.f);
            u0 = __builtin_amdgcn_mfma_f32_32x32x16_bf16(xa[0][0][s2], b0, u0, 0, 0, 0); u0 = __builtin_amdgcn_mfma_f32_32x32x16_bf16(xa[0][1][s2], b1, u0, 0, 0, 0);
            u1 = __builtin_amdgcn_mfma_f32_32x32x16_bf16(xa[1][0][s2], b0, u1, 0, 0, 0); u1 = __builtin_amdgcn_mfma_f32_32x32x16_bf16(xa[1][1][s2], b1, u1, 0, 0, 0); }
#pragma unroll
        for (int g = 0; g < 4; ++g) { v2u a, bq; a.x = pkbf(u0[4 * g], u0[4 * g + 1]); a.y = pkbf(u0[4 * g + 2], u0[4 * g + 3]); bq.x = pkbf(u1[4 * g], u1[4 * g + 1]); bq.y = pkbf(u1[4 * g + 2], u1[4 * g + 3]);
            *(v2u*)(wrow + 8 * g) = a; *(v2u*)(wrow + 32 + 8 * g) = bq; }
        S0 = S0 * gl; S1 = S1 * gl;
#pragma unroll
        for (int s2 = 0; s2 < 2; ++s2) { const bf16x8v b0 = pack8(u0, s2, 1.f), b1 = pack8(u1, s2, 1.f);
            S0 = __builtin_amdgcn_mfma_f32_32x32x16_bf16(ka[0][0][s2], b0, S0, 0, 0, 0); S0 = __builtin_amdgcn_mfma_f32_32x32x16_bf16(ka[0][1][s2], b1, S0, 0, 0, 0);
            S1 = __builtin_amdgcn_mfma_f32_32x32x16_bf16(ka[1][0][s2], b0, S1, 0, 0, 0); S1 = __builtin_amdgcn_mfma_f32_32x32x16_bf16(ka[1][1][s2], b1, S1, 0, 0, 0); }
    }
#undef DN2_LOADX
}
constexpr int G3_VS = 72;
__device__ __forceinline__ void gla3m_item(int item, int lane, LAS unsigned char* Lw, const bf16* ZBp, const float* ZFp, const float* wg, const float* bg, const float* BS, const float* gnorm, bf16* BRp) {
    asm volatile("" : "+v"(lane));
    const int chunk = item >> 2, h = item & 3, c = lane & 31, hh = lane >> 5; const size_t t0 = (size_t)chunk * 64;
    LAS bf16* vT = (LAS bf16*)Lw;
    bf16x8v kf[2][2], qf[2][2];
#pragma unroll
    for (int I = 0; I < 2; ++I)
#pragma unroll
        for (int s2 = 0; s2 < 2; ++s2) { const bf16* rp = ZBp + (t0 + 32 * I + c) * ZBW + h * 32 + 16 * s2 + 8 * hh;
            kf[I][s2] = __builtin_bit_cast(bf16x8v, *(const v4u*)(rp + ZB_GK)); qf[I][s2] = __builtin_bit_cast(bf16x8v, *(const v4u*)(rp + ZB_GQ)); }
    { const bf16* vp = ZBp + t0 * ZBW + ZB_GV + h * 64 + lane;
#pragma unroll 1
      for (int jh = 0; jh < 64; jh += 32) { unsigned short raw[32];
#pragma unroll
          for (int j = 0; j < 32; ++j) raw[j] = vp[(size_t)(jh + j) * ZBW];
#pragma unroll
          for (int j = 0; j < 32; ++j) vT[lane * G3_VS + jh + j] = raw[j]; } }
    LDS_WAIT(); asm volatile("" ::: "memory");
    f32x16 p00, p01, p11;
#pragma unroll
    for (int r = 0; r < 16; ++r) { p00[r] = 0.f; p01[r] = 0.f; p11[r] = 0.f; }
#pragma unroll
    for (int s2 = 0; s2 < 2; ++s2) { p00 = __builtin_amdgcn_mfma_f32_32x32x16_bf16(kf[0][s2], qf[0][s2], p00, 0, 0, 0); p01 = __builtin_amdgcn_mfma_f32_32x32x16_bf16(kf[0][s2], qf[1][s2], p01, 0, 0, 0);
        p11 = __builtin_amdgcn_mfma_f32_32x32x16_bf16(kf[1][s2], qf[1][s2], p11, 0, 0, 0); }
#pragma unroll
    for (int r = 0; r < 16; ++r) { const int j = (r & 3) + 8 * (r >> 2) + 4 * hh; if (j > c) { p00[r] = 0.f; p11[r] = 0.f; } }
    bf16x8v b00[2], b01[2], b11[2];
#pragma unroll
    for (int s2 = 0; s2 < 2; ++s2) { b00[s2] = pack8(p00, s2, 1.f); b01[s2] = pack8(p01, s2, 1.f); b11[s2] = pack8(p11, s2, 1.f); }
    f32x16 o[2][2];
#pragma unroll
    for (int V = 0; V < 2; ++V) { f32x16 a0, a1;
#pragma unroll
        for (int r = 0; r < 16; ++r) { a0[r] = 0.f; a1[r] = 0.f; }
        const float* sp = BS + (size_t)item * 2048 + 32 * V + c;
#pragma unroll
        for (int s2 = 0; s2 < 2; ++s2) { float sv[8];
#pragma unroll
            for (int e = 0; e < 8; ++e) sv[e] = sp[(16 * s2 + 8 * hh + e) * 64];
            v4u w; w.x = pkbf(sv[0], sv[1]); w.y = pkbf(sv[2], sv[3]); w.z = pkbf(sv[4], sv[5]); w.w = pkbf(sv[6], sv[7]); const bf16x8v sa = __builtin_bit_cast(bf16x8v, w);
            a0 = __builtin_amdgcn_mfma_f32_32x32x16_bf16(sa, qf[0][s2], a0, 0, 0, 0); a1 = __builtin_amdgcn_mfma_f32_32x32x16_bf16(sa, qf[1][s2], a1, 0, 0, 0);
            const LAS bf16* vr = vT + (32 * V + c) * G3_VS + 16 * s2 + 4 * hh;
            const v2u l0 = *(const LAS v2u*)vr, h0 = *(const LAS v2u*)(vr + 8), l1 = *(const LAS v2u*)(vr + 32), h1 = *(const LAS v2u*)(vr + 40);
            const bf16x8v va0 = __builtin_bit_cast(bf16x8v, (v4u){l0.x, l0.y, h0.x, h0.y}), va1 = __builtin_bit_cast(bf16x8v, (v4u){l1.x, l1.y, h1.x, h1.y});
            a0 = __builtin_amdgcn_mfma_f32_32x32x16_bf16(va0, b00[s2], a0, 0, 0, 0);
            a1 = __builtin_amdgcn_mfma_f32_32x32x16_bf16(va0, b01[s2], a1, 0, 0, 0); a1 = __builtin_amdgcn_mfma_f32_32x32x16_bf16(va1, b11[s2], a1, 0, 0, 0); }
        o[V][0] = a0; o[V][1] = a1; }
    v2u zw8[2][8]; f32x4 gn8[8];
#pragma unroll
    for (int q = 0; q < 8; ++q) { gn8[q] = *(const f32x4*)(gnorm + 32 * (q >> 2) + 8 * (q & 3) + 4 * hh);
#pragma unroll
        for (int I = 0; I < 2; ++I) zw8[I][q] = *(const v2u*)(ZBp + (t0 + 32 * I + c) * ZBW + ZB_GOG + h * 64 + 4 * hh + 32 * (q >> 2) + 8 * (q & 3)); }
#pragma unroll
    for (int I = 0; I < 2; ++I) { float ss = 0.f;
#pragma unroll
        for (int r = 0; r < 16; ++r) ss += o[0][I][r] * o[0][I][r] + o[1][I][r] * o[1][I][r];
        ss += __shfl_xor(ss, 32);
        const float rinv = 1.0f / sqrtf(ss * (1.f / 64.f) + EPS); const size_t t = t0 + 32 * I + c;
        bf16* op = BRp + t * 1024 + 512 + h * 64 + 4 * hh;
#pragma unroll
        for (int V = 0; V < 2; ++V)
#pragma unroll
            for (int g = 0; g < 4; ++g) { const int v0 = 32 * V + 8 * g; const v2u zw = zw8[I][V * 4 + g]; const f32x4 gn = gn8[V * 4 + g];
                const float z0 = bflo(zw.x), z1 = bfhi(zw.x), z2 = bflo(zw.y), z3 = bfhi(zw.y);
                v2u ow; ow.x = pkbf(o[V][I][4 * g] * rinv * gn[0] * z0 * sigmoidf_(z0), o[V][I][4 * g + 1] * rinv * gn[1] * z1 * sigmoidf_(z1));
                ow.y = pkbf(o[V][I][4 * g + 2] * rinv * gn[2] * z2 * sigmoidf_(z2), o[V][I][4 * g + 3] * rinv * gn[3] * z3 * sigmoidf_(z3));
                *(v2u*)(op + v0) = ow; } }
    LDS_WAIT(); asm volatile("" ::: "memory");
}
__device__ __forceinline__ void dn3_item(int item, int lane, const bf16* QD, const bf16* AT, const bf16* SNT, const bf16* WT, const bf16* ZBp, const float* gnp, bf16* BRp) {
    const int chunk = item >> 2, h = item & 3, c = lane & 31, hh = lane >> 5; const size_t t0 = (size_t)chunk * 64, ib = (size_t)item * 4096;
    f32x16 o[2][2];
#pragma unroll
    for (int I = 0; I < 2; ++I)
#pragma unroll
        for (int J = 0; J < 2; ++J)
#pragma unroll
            for (int r = 0; r < 16; ++r) o[I][J][r] = 0.f;
#pragma unroll
    for (int s4 = 0; s4 < 4; ++s4) { bf16x8v qa[2], aa[2], sb[2], ub[2];
#pragma unroll
        for (int I = 0; I < 2; ++I) { const size_t off = ib + (32 * I + c) * 64 + 16 * s4 + 8 * hh;
            qa[I] = __builtin_bit_cast(bf16x8v, *(const v4u*)(QD + off)); aa[I] = __builtin_bit_cast(bf16x8v, *(const v4u*)(AT + off));
            sb[I] = __builtin_bit_cast(bf16x8v, *(const v4u*)(SNT + off)); ub[I] = __builtin_bit_cast(bf16x8v, *(const v4u*)(WT + off)); }
#pragma unroll
        for (int I = 0; I < 2; ++I)
#pragma unroll
            for (int J = 0; J < 2; ++J) { o[I][J] = __builtin_amdgcn_mfma_f32_32x32x16_bf16(qa[I], sb[J], o[I][J], 0, 0, 0); o[I][J] = __builtin_amdgcn_mfma_f32_32x32x16_bf16(aa[I], ub[J], o[I][J], 0, 0, 0); } }
    const float gn0 = gnp[c], gn1 = gnp[32 + c];
    unsigned short zr[2][16][2];
#pragma unroll
    for (int I = 0; I < 2; ++I)
#pragma unroll
        for (int r = 0; r < 16; ++r) { const bf16* zp = ZBp + (t0 + 32 * I + (r & 3) + 8 * (r >> 2) + 4 * hh) * ZBW + ZB_DZ + h * 64 + c; zr[I][r][0] = zp[0]; zr[I][r][1] = zp[32]; }
#pragma unroll
    for (int I = 0; I < 2; ++I)
#pragma unroll
        for (int r = 0; r < 16; ++r) { float ss = o[I][0][r] * o[I][0][r] + o[I][1][r] * o[I][1][r];
            ss = dpp_row_sum(ss); ss += __shfl_xor(ss, 16);
            const float rinv = 1.0f / sqrtf(ss * (1.f / 64.f) + EPS);
            const size_t t = t0 + 32 * I + (r & 3) + 8 * (r >> 2) + 4 * hh;
            bf16* op = BRp + t * 1024 + 768 + h * 64 + c;
            const float z0 = bf2f(zr[I][r][0]), z1 = bf2f(zr[I][r][1]);
            op[0] = (bf16)f2bf(o[I][0][r] * rinv * gn0 * z0 * sigmoidf_(z0)); op[32] = (bf16)f2bf(o[I][1][r] * rinv * gn1 * z1 * sigmoidf_(z1)); }
}

constexpr int AT_KS = 104, AT_VS = 68, AT_KBYTES = 64 * AT_KS * 2, AT_VBYTES = 64 * AT_VS * 2, AT_STAGE = AT_KBYTES + AT_VBYTES;
__device__ __forceinline__ void attn_unit(LAS unsigned char* lds, int b, int h, int qb, int tid, const bf16* Qp, const bf16* Kp, const bf16* VTp, bf16* BRp) {
    const int lane = tid & 63, wave = __builtin_amdgcn_readfirstlane(tid >> 6), c = lane & 31, hh = lane >> 5;
    const bool grpB = wave >= 4;
    const int qpos = 256 * qb + 32 * wave + c; const size_t tq = (size_t)b * SEQ + qpos;
    const float c2 = 0.10206207261596577f * 1.4426950408889634f;
    bf16x8v qf[6];
#pragma unroll
    for (int s6 = 0; s6 < 6; ++s6) qf[s6] = __builtin_bit_cast(bf16x8v, *(const v4u*)(Qp + (tq * 4 + h) * 96 + 16 * s6 + 8 * hh));
    f32x16 o0, o1;
#pragma unroll
    for (int r = 0; r < 16; ++r) { o0[r] = 0.f; o1[r] = 0.f; }
    float mrun = -INFINITY, lrun = 0.f;
    const int nt = 4 * (qb + 1);
    const int kr0 = tid / 12, kc0 = tid - 12 * kr0, kr1 = (tid + 512) / 12, kc1 = (tid + 512) - 12 * kr1; const bool k2 = tid < 256;
    const int vr = tid >> 3, vc = tid & 7;
    const bf16* kg = Kp + ((size_t)b * SEQ * 4 + h) * 96; const bf16* vg = VTp + ((size_t)(b * 4 + h) * 64 + vr) * SEQ + 8 * vc;
    v4u sk0, sk1, sv;
    sk0 = *(const v4u*)(kg + (size_t)kr0 * 384 + 8 * kc0); if (k2) sk1 = *(const v4u*)(kg + (size_t)kr1 * 384 + 8 * kc1); sv = *(const v4u*)vg;
    { LAS unsigned char* st = lds; *(LAS v4u*)(st + kr0 * (AT_KS * 2) + 16 * kc0) = sk0; if (k2) *(LAS v4u*)(st + kr1 * (AT_KS * 2) + 16 * kc1) = sk1;
      LAS unsigned char* vt = st + AT_KBYTES + vr * (AT_VS * 2) + 16 * vc; *(LAS v2u*)vt = (v2u){sv.x, sv.y}; *(LAS v2u*)(vt + 8) = (v2u){sv.z, sv.w}; }
    __syncthreads();
    bf16x8v pf[4]; bool pend = false; int pstage = 0;
#define AT_PV(stg) do { const LAS unsigned char* vtb_ = lds + (stg) * AT_STAGE + AT_KBYTES + c * (AT_VS * 2) + 8 * hh; \
        _Pragma("unroll") for (int kb = 0; kb < 2; ++kb) _Pragma("unroll") for (int s2 = 0; s2 < 2; ++s2) { const LAS unsigned char* va = vtb_ + (32 * kb + 16 * s2) * 2; \
            const v2u a0l = *(const LAS v2u*)va, a0h = *(const LAS v2u*)(va + 16), a1l = *(const LAS v2u*)(va + 32 * (AT_VS * 2)), a1h = *(const LAS v2u*)(va + 32 * (AT_VS * 2) + 16); \
            const bf16x8v av0 = __builtin_bit_cast(bf16x8v, (v4u){a0l.x, a0l.y, a0h.x, a0h.y}), av1 = __builtin_bit_cast(bf16x8v, (v4u){a1l.x, a1l.y, a1h.x, a1h.y}); \
            o0 = __builtin_amdgcn_mfma_f32_32x32x16_bf16(av0, pf[2 * kb + s2], o0, 0, 0, 0); o1 = __builtin_amdgcn_mfma_f32_32x32x16_bf16(av1, pf[2 * kb + s2], o1, 0, 0, 0); } } while (0)
    int stg = 0;
    for (int t = 0; t < nt; ++t) {
        const bool more = (t + 1 < nt);
        if (more) { const size_t k0 = (size_t)(t + 1) * 64; sk0 = *(const v4u*)(kg + (k0 + kr0) * 384 + 8 * kc0); if (k2) sk1 = *(const v4u*)(kg + (k0 + kr1) * 384 + 8 * kc1); sv = *(const v4u*)(vg + k0); }
        if (pend) { AT_PV(pstage); pend = false; }
        const LAS unsigned char* st = lds + stg * AT_STAGE;
        const int tt = t - (nt - 4);
        const bool active = (tt < 0) || (64 * tt <= 32 * wave + 31);
        if (active) {
            f32x16 p0, p1;
            { const bf16x8v a0 = *(const LAS bf16x8v*)(st + c * (AT_KS * 2) + 16 * hh), a1 = *(const LAS bf16x8v*)(st + (32 + c) * (AT_KS * 2) + 16 * hh);
              const f32x16 zz = {0.f, 0.f, 0.f, 0.f, 0.f, 0.f, 0.f, 0.f, 0.f, 0.f, 0.f, 0.f, 0.f, 0.f, 0.f, 0.f};
              p0 = __builtin_amdgcn_mfma_f32_32x32x16_bf16(a0, qf[0], zz, 0, 0, 0); p1 = __builtin_amdgcn_mfma_f32_32x32x16_bf16(a1, qf[0], zz, 0, 0, 0); }
#pragma unroll
            for (int s6 = 1; s6 < 6; ++s6) { const bf16x8v a0 = *(const LAS bf16x8v*)(st + c * (AT_KS * 2) + 32 * s6 + 16 * hh), a1 = *(const LAS bf16x8v*)(st + (32 + c) * (AT_KS * 2) + 32 * s6 + 16 * hh);
                p0 = __builtin_amdgcn_mfma_f32_32x32x16_bf16(a0, qf[s6], p0, 0, 0, 0); p1 = __builtin_amdgcn_mfma_f32_32x32x16_bf16(a1, qf[s6], p1, 0, 0, 0); }
            if (tt >= 0 && (64 * tt + 63 > 32 * wave)) { const int kb0 = 64 * t + 4 * hh;
#pragma unroll
                for (int r = 0; r < 16; ++r) { const int key = kb0 + (r & 3) + 8 * (r >> 2); if (key > qpos) p0[r] = -INFINITY; if (key + 32 > qpos) p1[r] = -INFINITY; } }
            float tmax = fmaxf(p0[0], p1[0]);
#pragma unroll
            for (int r = 1; r < 16; ++r) tmax = fmaxf(tmax, fmaxf(p0[r], p1[r]));
            tmax = fmaxf(tmax, __shfl_xor(tmax, 32));
            const float mnew = fmaxf(mrun, tmax); const float mc = mnew * c2;
            if (__any(mnew > mrun)) { const float alpha = __builtin_amdgcn_exp2f((mrun - mnew) * c2); lrun *= alpha; o0 = o0 * alpha; o1 = o1 * alpha; }
            float rs = 0.f;
#pragma unroll
            for (int r = 0; r < 16; ++r) { p0[r] = __builtin_amdgcn_exp2f(p0[r] * c2 - mc); p1[r] = __builtin_amdgcn_exp2f(p1[r] * c2 - mc); rs += p0[r] + p1[r]; }
            rs += __shfl_xor(rs, 32);
            lrun += rs; mrun = mnew;
            pf[0] = pack8(p0, 0, 1.f); pf[1] = pack8(p0, 1, 1.f); pf[2] = pack8(p1, 0, 1.f); pf[3] = pack8(p1, 1, 1.f);
            if (grpB) { pend = true; pstage = stg; } else { AT_PV(stg); }
        }
        const int nstg = (stg == 2) ? 0 : stg + 1;
        if (more) { LAS unsigned char* sn = lds + nstg * AT_STAGE; *(LAS v4u*)(sn + kr0 * (AT_KS * 2) + 16 * kc0) = sk0; if (k2) *(LAS v4u*)(sn + kr1 * (AT_KS * 2) + 16 * kc1) = sk1;
            LAS unsigned char* vt = sn + AT_KBYTES + vr * (AT_VS * 2) + 16 * vc; *(LAS v2u*)vt = (v2u){sv.x, sv.y}; *(LAS v2u*)(vt + 8) = (v2u){sv.z, sv.w}; }
        stg = nstg;
        __syncthreads();
    }
    if (pend) { AT_PV(pstage); }
#undef AT_PV
    const float il = 1.0f / lrun; bf16* op = BRp + tq * 1024 + h * 64 + 4 * hh;
#pragma unroll
    for (int g = 0; g < 4; ++g) { v2u w0, w1; w0.x = pkbf(o0[4 * g] * il, o0[4 * g + 1] * il); w0.y = pkbf(o0[4 * g + 2] * il, o0[4 * g + 3] * il); w1.x = pkbf(o1[4 * g] * il, o1[4 * g + 1] * il); w1.y = pkbf(o1[4 * g + 2] * il, o1[4 * g + 3] * il);
        *(v2u*)(op + 8 * g) = w0; *(v2u*)(op + 32 + 8 * g) = w1; }
    __syncthreads();
}
constexpr int XA_RS = 264, XA_TB = 64 * XA_RS * 2;
__device__ __forceinline__ void xattn_unit(LAS unsigned char* lds, int b, int h, int qb, int tid, const bf16* XQp, const bf16* KXp, const bf16* VXTp, bf16* XOp, const float* ssq16) {
    const int lane = tid & 63, wave = __builtin_amdgcn_readfirstlane(tid >> 6), c = lane & 31, hh = lane >> 5;
    const size_t tq = (size_t)b * SEQ + 256 * qb + 32 * wave + c;
    const float c2 = 0.0625f * 1.4426950408889634f * row_rscale(ssq16, tq);
    const bf16* qp = XQp + tq * 1024 + h * 256 + 8 * hh;
    const int ch = tid & 31, r0 = tid >> 5;
#define XA_STAGE2(j0, isv) do { v4u st8[2][4]; _Pragma("unroll") for (int jj = 0; jj < 2; ++jj) { const int j = (j0) + jj; \
            const bf16* base = (isv) ? VXTp + ((size_t)((b * 4 + h) * 256 + 64 * j)) * 256 : KXp + ((size_t)(b * 256 + 64 * j)) * 1024 + h * 256; const int rs = (isv) ? 256 : 1024; \
            _Pragma("unroll") for (int i = 0; i < 4; ++i) st8[jj][i] = *(const v4u*)(base + (size_t)(r0 + 16 * i) * rs + 8 * ch); } \
        _Pragma("unroll") for (int jj = 0; jj < 2; ++jj) { LAS unsigned char* sb = lds + ((j0) + jj) * XA_TB; _Pragma("unroll") for (int i = 0; i < 4; ++i) *(LAS v4u*)(sb + (r0 + 16 * i) * (XA_RS * 2) + 16 * ch) = st8[jj][i]; } } while (0)
    XA_STAGE2(0, false); XA_STAGE2(2, false);
    __syncthreads();
    f32x16 p[8];
#pragma unroll
    for (int j = 0; j < 8; ++j)
#pragma unroll
        for (int r = 0; r < 16; ++r) p[j][r] = 0.f;
#pragma unroll
    for (int sc = 0; sc < 4; ++sc) { bf16x8v qf[4];
#pragma unroll
        for (int i = 0; i < 4; ++i) qf[i] = __builtin_bit_cast(bf16x8v, *(const v4u*)(qp + 16 * (4 * sc + i)));
#pragma unroll
        for (int kb = 0; kb < 8; ++kb) { const LAS unsigned char* kt = lds + (kb >> 1) * XA_TB + (32 * (kb & 1) + c) * (XA_RS * 2) + 32 * (4 * sc) + 16 * hh;
#pragma unroll
            for (int i = 0; i < 4; ++i) p[kb] = __builtin_amdgcn_mfma_f32_32x32x16_bf16(*(const LAS bf16x8v*)(kt + 32 * i), qf[i], p[kb], 0, 0, 0); } }
    float mx = p[0][0];
#pragma unroll
    for (int j = 0; j < 8; ++j)
#pragma unroll
        for (int r = 0; r < 16; ++r) mx = fmaxf(mx, p[j][r]);
    mx = fmaxf(mx, __shfl_xor(mx, 32));
    const float mc = mx * c2; float rs = 0.f;
#pragma unroll
    for (int j = 0; j < 8; ++j)
#pragma unroll
        for (int r = 0; r < 16; ++r) { p[j][r] = __builtin_amdgcn_exp2f(p[j][r] * c2 - mc); rs += p[j][r]; }
    rs += __shfl_xor(rs, 32);
    const float il = 1.0f / rs;
    bf16x8v pf[16];
#pragma unroll
    for (int kb = 0; kb < 8; ++kb) { pf[2 * kb] = pack8(p[kb], 0, 1.f); pf[2 * kb + 1] = pack8(p[kb], 1, 1.f); }
    __syncthreads();
    XA_STAGE2(0, true); XA_STAGE2(2, true);
    __syncthreads();
    bf16* op = XOp + tq * 1024 + h * 256 + 4 * hh;
#pragma unroll 1
    for (int j = 0; j < 4; ++j) { const LAS unsigned char* st = lds + j * XA_TB;
        f32x16 o0, o1;
#pragma unroll
        for (int r = 0; r < 16; ++r) { o0[r] = 0.f; o1[r] = 0.f; }
#pragma unroll
        for (int ks = 0; ks < 16; ++ks) { const LAS unsigned char* va = st + c * (XA_RS * 2) + 32 * ks + 8 * hh;
            const v2u a0l = *(const LAS v2u*)va, a0h = *(const LAS v2u*)(va + 16), a1l = *(const LAS v2u*)(va + 32 * (XA_RS * 2)), a1h = *(const LAS v2u*)(va + 32 * (XA_RS * 2) + 16);
            const bf16x8v av0 = __builtin_bit_cast(bf16x8v, (v4u){a0l.x, a0l.y, a0h.x, a0h.y}), av1 = __builtin_bit_cast(bf16x8v, (v4u){a1l.x, a1l.y, a1h.x, a1h.y});
            o0 = __builtin_amdgcn_mfma_f32_32x32x16_bf16(av0, pf[ks], o0, 0, 0, 0); o1 = __builtin_amdgcn_mfma_f32_32x32x16_bf16(av1, pf[ks], o1, 0, 0, 0); }
        bf16* oq = op + 64 * j;
#pragma unroll
        for (int g = 0; g < 4; ++g) { v2u w0, w1; w0.x = pkbf(o0[4 * g] * il, o0[4 * g + 1] * il); w0.y = pkbf(o0[4 * g + 2] * il, o0[4 * g + 3] * il); w1.x = pkbf(o1[4 * g] * il, o1[4 * g + 1] * il); w1.y = pkbf(o1[4 * g + 2] * il, o1[4 * g + 3] * il);
            *(v2u*)(oq + 8 * g) = w0; *(v2u*)(oq + 32 + 8 * g) = w1; } }
    __syncthreads();
#undef XA_STAGE2
}

constexpr int SG_RS = 136;
__device__ __forceinline__ void sg_chunk(LAS unsigned char* lds, int chunk, int tid, const bf16* ZAp, const bf16* Wm, const float* lng, const float* lnb, const float* sgb, bf16* BRp) {
    const int lane = tid & 63, wave = __builtin_amdgcn_readfirstlane(tid >> 6); const size_t t0 = (size_t)chunk * 128;
    LAS bf16* vT = (LAS bf16*)lds;
#pragma unroll 1
    for (int r0 = wave; r0 < 128; r0 += 32) { unsigned short raw[4][4];
#pragma unroll
        for (int q = 0; q < 4; ++q)
#pragma unroll
            for (int i = 0; i < 4; ++i) raw[q][i] = ZAp[(t0 + r0 + 8 * q) * 1024 + Z_SGV + lane + 64 * i];
#pragma unroll
        for (int q = 0; q < 4; ++q) { const int r = r0 + 8 * q; float gv[4]; float sm = 0.f;
#pragma unroll
            for (int i = 0; i < 4; ++i) { gv[i] = gelu_tanh(bf2f(raw[q][i])); sm += gv[i]; }
            const float mean = wave_sum(sm) * (1.f / 256.f); float qq = 0.f;
#pragma unroll
            for (int i = 0; i < 4; ++i) { gv[i] -= mean; qq += gv[i] * gv[i]; }
            const float rstd = 1.0f / sqrtf(wave_sum(qq) * (1.f / 256.f) + EPS);
#pragma unroll
            for (int i = 0; i < 4; ++i) { const int ch = lane + 64 * i; vT[ch * SG_RS + r] = (bf16)f2bf(gv[i] * rstd * lng[ch] + lnb[ch]); } } }
    __syncthreads();
    { const int g = wave >> 1, ct = wave & 1, c = lane & 31, hh = lane >> 5; const int ch = g * 64 + ct * 32 + c;
      f32x16 acc[4];
#pragma unroll
      for (int I = 0; I < 4; ++I)
#pragma unroll
          for (int r = 0; r < 16; ++r) acc[I][r] = 0.f;
#pragma unroll
      for (int s = 0; s < 8; ++s) { const bf16x8v bfr = *(const LAS bf16x8v*)(vT + ch * SG_RS + 16 * s + 8 * hh);
#pragma unroll
          for (int I = 0; I < 4; ++I) if (16 * s < 32 * (I + 1)) { const bf16x8v afr = __builtin_bit_cast(bf16x8v, *(const v4u*)(Wm + ((size_t)g * 128 + 32 * I + c) * 128 + 16 * s + 8 * hh));
              acc[I] = __builtin_amdgcn_mfma_f32_32x32x16_bf16(afr, bfr, acc[I], 0, 0, 0); } }
#pragma unroll
      for (int I = 0; I < 4; ++I) { unsigned short ur[16];
#pragma unroll
          for (int r = 0; r < 16; ++r) { const int i = 32 * I + (r & 3) + 8 * (r >> 2) + 4 * hh; ur[r] = ZAp[(t0 + i) * 1024 + Z_SGU + ch]; }
#pragma unroll
          for (int r = 0; r < 16; ++r) { const int i = 32 * I + (r & 3) + 8 * (r >> 2) + 4 * hh; const size_t t = t0 + i;
              const float uu = gelu_tanh(bf2f(ur[r])); BRp[t * 1024 + 256 + ch] = (bf16)f2bf(uu * (acc[I][r] + sgb[g * 128 + i])); } } }
    __syncthreads();
}

struct Args { const void* in[32]; float* out; unsigned char* ws; int ph_lo, ph_hi; };
constexpr int NPH_L = 15, NPHASES = DEPTH * NPH_L + 1;

#ifndef MK_N_LAUNCHES
#define MK_N_LAUNCHES 1
#endif

#define KIN(k) (apl->in[k])
#define x_in ((const float*)(const GAS float*)KIN(0))
#define mem ((const float*)(const GAS float*)KIN(1))
#define positions ((const int*)(const GAS int*)KIN(2))
#define norm_mix ((const float*)(const GAS float*)KIN(3))
#define w_in ((const float*)(const GAS float*)KIN(4))
#define mla_nq ((const float*)(const GAS float*)KIN(5))
#define mla_nkv ((const float*)(const GAS float*)KIN(6))
#define mla_wuq ((const float*)(const GAS float*)KIN(7))
#define mla_wukv ((const float*)(const GAS float*)KIN(8))
#define sg_ln_g ((const float*)(const GAS float*)KIN(9))
#define sg_ln_b ((const float*)(const GAS float*)KIN(10))
#define sg_w ((const float*)(const GAS float*)KIN(11))
#define sg_b ((const float*)(const GAS float*)KIN(12))
#define gla_wg ((const float*)(const GAS float*)KIN(13))
#define gla_bg ((const float*)(const GAS float*)KIN(14))
#define gla_norm ((const float*)(const GAS float*)KIN(15))
#define dn_conv ((const float*)(const GAS float*)KIN(16))
#define dn_alog ((const float*)(const GAS float*)KIN(17))
#define dn_dtb ((const float*)(const GAS float*)KIN(18))
#define dn_norm ((const float*)(const GAS float*)KIN(19))
#define w_branch ((const float*)(const GAS float*)KIN(20))
#define w_out ((const float*)(const GAS float*)KIN(21))
#define norm_xattn ((const float*)(const GAS float*)KIN(22))
#define norm_mem ((const float*)(const GAS float*)KIN(23))
#define xwq ((const float*)(const GAS float*)KIN(24))
#define xwk ((const float*)(const GAS float*)KIN(25))
#define xwv ((const float*)(const GAS float*)KIN(26))
#define xwo ((const float*)(const GAS float*)KIN(27))
#define norm_mlp ((const float*)(const GAS float*)KIN(28))
#define w_up ((const float*)(const GAS float*)KIN(29))
#define w_down ((const float*)(const GAS float*)KIN(30))
#define norm_final ((const float*)(const GAS float*)KIN(31))
#define ROPEC ((float*)(wsl + WS_ROPEC))
#define ROPES ((float*)(wsl + WS_ROPES))
#define KX ((bf16*)(wsl + WS_KX))
#define VX ((bf16*)(wsl + WS_VX))
#define MEMN ((bf16*)(wsl + WS_MEMN))
#define Wz ((bf16*)(wsl + WS_WZ))
#define Wmla ((bf16*)(wsl + WS_WMLA))
#define Wmrg ((bf16*)(wsl + WS_WMRG))
#define Wpj ((bf16*)(wsl + WS_WMRG + 8 * MiB))
#define PJ ((bf16*)(wsl + WS_PJ))
#define Wout ((bf16*)(wsl + WS_WOUT))
#define Wxq ((bf16*)(wsl + WS_WXQ))
#define Wxk ((bf16*)(wsl + WS_WXK))
#define Wxv ((bf16*)(wsl + WS_WXV))
#define Wxo ((bf16*)(wsl + WS_WXO))
#define Wup ((bf16*)(wsl + WS_WUP))
#define Wdn ((bf16*)(wsl + WS_WDN))
#define HB ((bf16*)(wsl + WS_HB))
#define BR ((bf16*)(wsl + WS_BR))
#define ZA ((bf16*)(wsl + WS_ZA))
#define ZB ((bf16*)(wsl + WS_ZB))
#define ZF ((float*)(wsl + WS_ZF))
#define SSQ ((float*)(wsl + WS_SSQ))
#define SS16 ((float*)(wsl + WS_SS16))
#define SS16B ((float*)(wsl + WS_SS16B))
#define R1 ((float*)(wsl + WS_R1))
#define WSM ((bf16*)(wsl + WS_WSM))
#define QB ((bf16*)(wsl + WS_Q))
#define KB ((bf16*)(wsl + WS_K))
#define VB ((bf16*)(wsl + WS_V))
#define MG ((bf16*)(wsl + WS_MG))
#define XQ ((bf16*)(wsl + WS_XQ))
#define XO ((bf16*)(wsl + WS_XO))
#define HID ((bf16*)(wsl + WS_HID))
#define XR (args.out)
#define OUTB ((unsigned char*)(GAS unsigned char*)args.out)
#define XCb ((bf16*)(OUTB + 0 * MiB))
#define WTb ((bf16*)(OUTB + 16 * MiB))
#define KDTb ((bf16*)(OUTB + 32 * MiB))
#define QDb ((bf16*)(OUTB + 48 * MiB))
#define ATb ((bf16*)(wsl + WS_AT))
#define BSb ((float*)(wsl + WS_BS))
#define EGb ((float*)(wsl + WS_EG))
#define GLb ((float*)(wsl + WS_GL))
#define SNTb ((bf16*)(wsl + WS_SNT))
__global__ void __launch_bounds__(NWAVES * 64, 2) skel_fwd(Args args) {
    extern __shared__ __attribute__((aligned(16))) unsigned char lds_raw[];
    Frame F;
    F.lds = (LAS unsigned char*)lds_raw;
    volatile LAS unsigned* MISC = (volatile LAS unsigned*)(F.lds + MISC_OFF);
    F.tid = threadIdx.x; F.lane = F.tid & 63; F.wave = __builtin_amdgcn_readfirstlane(F.tid >> 6);
    F.G = gridDim.x; { const int bx = blockIdx.x; F.vcu = (F.G % 8 == 0) ? (bx % 8) * (F.G / 8) + bx / 8 : bx; }
    unsigned char* ws = args.ws;
    gu32* ctl = (gu32*)(ws + WS_CTL);
    for (int u = F.tid; u < (LDS_BYTES - LDSCTL_OFF) / 4; u += NWAVES * 64) ((LAS unsigned*)(F.lds + LDSCTL_OFF))[u] = 0u;
    __syncthreads();
    const int lo = args.ph_lo, hi = args.ph_hi;
    const bool use_bar = (hi - lo) > 1;
    XcdBarrier bar; bar.bar = (unsigned*)(ctl + CW_BAR); bar.x = 0; bar.st = nullptr;
    if (use_bar) bar = xcd_barrier_post((unsigned*)(ctl + CW_BAR), MISC + 8);
#define IN(k) (lo <= (k) && (k) < hi)
#define SEAM(k) do { if ((k) + 1 < hi) xcd_barrier(bar); } while (0)

    unsigned char* wsl = ws;
    typedef __attribute__((address_space(4))) const Args* KArgP; KArgP apl = (KArgP)__builtin_amdgcn_kernarg_segment_ptr();
    int gw, gtid; const int NGW = F.G * NWAVES, NGT = F.G * NWAVES * 64;
#define PHASE_BEGIN() do { int t_ = threadIdx.x; asm volatile("" : "+v"(t_)); F.tid = t_; F.lane = t_ & 63; F.wave = __builtin_amdgcn_readfirstlane(t_ >> 6); { size_t wo_ = 0; asm volatile("" : "+s"(wo_)); wsl = ws + wo_; apl = (KArgP)((__attribute__((address_space(4))) const char*)__builtin_amdgcn_kernarg_segment_ptr() + wo_); } gw =F.vcu * NWAVES + F.wave; gtid = F.vcu * (NWAVES * 64) + F.tid; } while (0)

    if (IN(0)) { PHASE_BEGIN(); for (int i = gtid; i < T * 16; i += NGT) { float c, s; rope_entry(positions[i >> 4], i & 15, c, s); ROPEC[i] = c; ROPES[i] = s; } }
    for (int l = 0; l < DEPTH; ++l) {
        const int pb = l * NPH_L;

        if (IN(pb + 0)) { PHASE_BEGIN();
            LAS float* scr = (LAS float*)(F.lds + RING_OFF + F.wave * 16384);
            const float* win_l = w_in + (size_t)l * D * INW;
            constexpr int T_WZ = (ZW / 32) * (D / 64), T_MLA = 32 * 8, T_MRG = 128 * 16, T_WP = 4 * 32 * 4, T_SQ = 32 * 16, T_UP = 128 * 16, T_DN = 32 * 64;
            constexpr int NTILES = T_WZ + T_MLA + T_MRG + T_WP + 5 * T_SQ + T_UP + T_DN;
            for (int it = gw; it < NTILES; it += NGW) {
                int r = it;
                if (r < T_WZ) { FnWz f{win_l, norm_mix + l * D}; wprep_tile(f, Wz, D, (r / 16) * 32, (r % 16) * 64, scr, F.lane); continue; } r -= T_WZ;
                if (r < T_MLA) { const int R0 = (r / 8) * 32, k0 = (r % 8) * 64;
                    if (R0 < 384 && k0 < 256) { FnWuq f{mla_wuq + (size_t)l * 256 * 384, mla_nq + l * 256}; wprep_tile(f, Wmla, 512, R0, k0, scr, F.lane); }
                    else if (R0 >= 384 && R0 < 896 && k0 >= 256 && k0 < 384) { FnWukv f{mla_wukv + (size_t)l * 128 * 512, mla_nkv + l * 128}; wprep_tile(f, Wmla, 512, R0, k0, scr, F.lane); }
                    else if (R0 >= 896 && R0 < 928) { FnIdent f; wprep_tile(f, Wmla, 512, R0, k0, scr, F.lane); }
                    else { FnZero f; wprep_tile(f, Wmla, 512, R0, k0, scr, F.lane); }
                    continue; } r -= T_MLA;
                if (r < T_MRG) { FnWmrg f{win_l, norm_mix + l * D}; wprep_tile(f, Wmrg, 1024, (r / 16) * 32, (r % 16) * 64, scr, F.lane); continue; } r -= T_MRG;
                if (r < T_WP) { const int gte = r >> 7, rr2 = r & 127; FnT<false> f{w_branch + ((size_t)l * 4 + gte) * 256 * 1024, 1024, nullptr}; wprep_tile(f, Wpj + (size_t)gte * 1024 * 256, 256, (rr2 >> 2) * 32, (rr2 & 3) * 64, scr, F.lane); continue; } r -= T_WP;
                const float* W; int N, Kd; bf16* dst; const float* gv = nullptr;
                if (r < 5 * T_SQ) { const int w = r / T_SQ; r -= w * T_SQ; N = D; Kd = D;
                    W = (w == 0) ? w_out + (size_t)l * D * D : (w == 1) ? xwq + (size_t)l * D * D : (w == 2) ? xwk + (size_t)l * D * D : (w == 3) ? xwv + (size_t)l * D * D : xwo + (size_t)l * D * D;
                    dst = (w == 0) ? Wout : (w == 1) ? Wxq : (w == 2) ? Wxk : (w == 3) ? Wxv : Wxo; if (w == 1) gv = norm_xattn + l * D; }
                else { r -= 5 * T_SQ; if (r < T_UP) { W = w_up + (size_t)l * D * FF; N = FF; Kd = D; dst = Wup; gv = norm_mlp + l * D; } else { r -= T_UP; W = w_down + (size_t)l * FF * D; N = D; Kd = FF; dst = Wdn; } }
                const int kt = Kd / 64; if (gv) { FnT<true> f{W, N, gv}; wprep_tile(f, dst, Kd, (r / kt) * 32, (r % kt) * 64, scr, F.lane); } else { FnT<false> f{W, N, nullptr}; wprep_tile(f, dst, Kd, (r / kt) * 32, (r % kt) * 64, scr, F.lane); }
            }
            if (l == 0) for (int m = gw; m < T; m += 2 * NGW) {
                const int m2 = m + NGW; const bool two = m2 < T;
                const GAS f32x4* xa = (const GAS f32x4*)(x_in + (size_t)m * D) + F.lane; const GAS f32x4* xb2 = (const GAS f32x4*)(x_in + (size_t)(two ? m2 : m) * D) + F.lane;
                f32x4 va[4], vb[4];
#pragma unroll
                for (int j = 0; j < 4; ++j) { va[j] = xa[64 * j]; vb[j] = xb2[64 * j]; }
                GAS unsigned long long* oa = (GAS unsigned long long*)(HB + (size_t)m * D) + F.lane; GAS unsigned long long* ob = (GAS unsigned long long*)(HB + (size_t)m2 * D) + F.lane; float sa = 0.f, sb = 0.f;
#pragma unroll
                for (int j = 0; j < 4; ++j) { sa += (va[j].x * va[j].x + va[j].y * va[j].y) + (va[j].z * va[j].z + va[j].w * va[j].w); sb += (vb[j].x * vb[j].x + vb[j].y * vb[j].y) + (vb[j].z * vb[j].z + vb[j].w * vb[j].w);
                    oa[64 * j] = (unsigned long long)pk2(va[j].x, va[j].y) | ((unsigned long long)pk2(va[j].z, va[j].w) << 32);
                    if (two) ob[64 * j] = (unsigned long long)pk2(vb[j].x, vb[j].y) | ((unsigned long long)pk2(vb[j].z, vb[j].w) << 32); }
                sa = wave_sum(sa); sb = wave_sum(sb);
                if (F.lane == 0) { R1[m] = 1.0f / sqrtf(sa * (1.f / 1024.f) + EPS); if (two) R1[m2] = 1.0f / sqrtf(sb * (1.f / 1024.f) + EPS); } }
            else for (int m = gtid; m < T; m += NGT) R1[m] = row_rscale(SS16, (size_t)m);
            for (int m = gw; m < MT; m += NGW) rms_row_bf16(mem + (size_t)m * D, norm_mem + l * D, MEMN + (size_t)m * D, F.lane);
            for (int i = gtid; i < 4 * 128 * 128; i += NGT) { const int ii = (i >> 7) & 127, jj = i & 127; WSM[i] = (bf16)f2bf(jj <= ii ? sg_w[(size_t)l * 65536 + i] : 0.f); }
            SEAM(pb + 0);
        }
        if (IN(pb + 1)) { PHASE_BEGIN();
            pg8::Gemm g{HB, nullptr, Wz, D, T, ZW, D, 1 << 20, 0}; pg8::StaticOrder S; S.init(T, ZW, F.G, (int)blockIdx.x);
            pg8::EpiZin E{ZA, ZB, SSQ, ZF, R1};
            pg8::gemm_phase<pg8::EpiZin, pg8::StaticOrder, true, true>(F.lds + RING_OFF, g, S, E);
            PHASE_BEGIN();
            { pg8::Gemm g{MEMN, nullptr, Wxk, D, MT, D, D, 1 << 20, 0}; pg8::StaticOrder S; S.init(MT, D, F.G, (int)((blockIdx.x + 128) % F.G));
              pg8::EpiBf16<0> E{KX, D, 1.f, nullptr, nullptr, nullptr};
              pg8::gemm_phase<pg8::EpiBf16<0>, pg8::StaticOrder, true, true>(F.lds + RING_OFF, g, S, E); }
            PHASE_BEGIN();
            { pg8::Gemm g{MEMN, nullptr, Wxv, D, MT, D, D, 1 << 20, 0}; pg8::StaticOrder S; S.init(MT, D, F.G, (int)((blockIdx.x + 96) % F.G));
              pg8::EpiBf16T E{VX};
              pg8::gemm_phase<pg8::EpiBf16T, pg8::StaticOrder, true, true>(F.lds + RING_OFF, g, S, E); }
            SEAM(pb + 1);
        }
        if (IN(pb + 2)) { PHASE_BEGIN();
            { pg8::Gemm g{ZA, nullptr, Wmla, 1024, T, 1024, 512, 1 << 20, 0}; pg8::StaticOrder S; S.init(T, 1024, F.G, (int)blockIdx.x);
              pg8::EpiMla E{QB, KB, VB, SSQ, ROPEC, ROPES};
              pg8::gemm_phase<pg8::EpiMla, pg8::StaticOrder, true, true>(F.lds + RING_OFF, g, S, E); }
            PHASE_BEGIN();
            for (int chunk = F.vcu; chunk < T / 128; chunk += F.G) sg_chunk(F.lds + RING_OFF, chunk, F.tid, ZA, WSM, sg_ln_g + l * 256, sg_ln_b + l * 256, sg_b + (size_t)l * 512, BR);
            SEAM(pb + 2);
        }
        if (IN(pb + 3)) { PHASE_BEGIN();
            if (F.wave < 4) { LAS float* Xk = (LAS float*)(F.lds + RING_OFF + F.wave * 34816); LAS float* Lm = Xk + 64 * XKS; const float* cw = dn_conv + (size_t)l * 4 * 768;
                for (int item = F.vcu * 4 + F.wave; item < 2048; item += F.G * 4) { const int h = item & 3; const int ln3 = (int)(threadIdx.x & 63u);
                    dn1_item(item, ln3, Xk, Lm, ZB, ZF, cw, __expf(dn_alog[l * 4 + h]), dn_dtb[l * 4 + h], XCb, WTb, KDTb, QDb, ATb, GLb); } }
            else { const float* wg = gla_wg + (size_t)l * 16 * 128; const float* bg = gla_bg + l * 128;
                for (int item = F.vcu * 4 + (F.wave - 4); item < 2048; item += F.G * 4) gla1_item(item, F.lane, ZB, ZF, wg, bg, BSb, EGb); }
            SEAM(pb + 3);
        }
        if (IN(pb + 4)) { PHASE_BEGIN();
            if (F.wave == 0) for (int w = F.vcu; w < 64; w += F.G) dn2_worker(w >> 1, w & 1, F.lane, XCb, WTb, KDTb, SNTb, GLb);
            for (int e = gtid - 64 * 512; e < 65536; e += NGT) if (e >= 0) { const int bh = e >> 11, kap = (e >> 6) & 31, v = e & 63, b = bh >> 2, h = bh & 3;
                float S = 0.f;
#pragma unroll 1
                for (int n0 = 0; n0 < 64; n0 += 32) { float Bn[32], Eg[32];
#pragma unroll
                    for (int n = 0; n < 32; ++n) { const int item = (b * 64 + n0 + n) * 4 + h; Bn[n] = BSb[(size_t)item * 2048 + kap * 64 + v]; Eg[n] = EGb[item * 32 + kap]; }
#pragma unroll
                    for (int n = 0; n < 32; ++n) { const int item = (b * 64 + n0 + n) * 4 + h; BSb[(size_t)item * 2048 + kap * 64 + v] = S; S = Eg[n] * (S + Bn[n]); } } }
            PHASE_BEGIN();
            __syncthreads();
            { unsigned* qctr = (unsigned*)(ctl + CW_Q + 64 * l); volatile LAS unsigned* qslot = MISC + 16;
              for (;;) { if (F.tid == 0) qslot[0] = __hip_atomic_fetch_add(qctr, 1u, __ATOMIC_RELAXED, __HIP_MEMORY_SCOPE_AGENT);
                  __syncthreads(); const unsigned u2 = qslot[0]; __syncthreads();
                  if (u2 >= 512u) break;
                  const int qb = 15 - (int)(u2 >> 5), bh = (int)(u2 & 31u);
                  attn_unit(F.lds + RING_OFF, bh >> 2, bh & 3, qb, F.tid, QB, KB, VB, BR); } }
            SEAM(pb + 4);
        }
        if (IN(pb + 5)) { PHASE_BEGIN();
            LAS float* Lw = (LAS float*)(F.lds + RING_OFF + F.wave * 17408);
            const float* wg = gla_wg + (size_t)l * 16 * 128; const float* bg = gla_bg + l * 128;
            const float gng = gla_norm[l * 64 + F.lane];
            for (int item = gw; item < 2048; item += NGW) {
                gla3m_item(item, F.lane, (LAS unsigned char*)Lw, ZB, ZF, wg, bg, BSb, gla_norm + l * 64, BR);
                dn3_item(item, F.lane, QDb, ATb, SNTb, WTb, ZB, dn_norm + l * 64, BR);
            }
            SEAM(pb + 5);
        }
        if (IN(pb + 6)) { PHASE_BEGIN();
            pg8::Gemm g{BR, nullptr, Wpj, D, T, 4096, 256, 1 << 20, 512}; pg8::StaticOrder S; S.init(T, 4096, F.G, (int)blockIdx.x);
            pg8::EpiBf16<0> E{PJ, 4096, 1.f, nullptr, nullptr, nullptr};
            pg8::gemm_phase<pg8::EpiBf16<0>, pg8::StaticOrder, true, true>(F.lds + RING_OFF, g, S, E);
            SEAM(pb + 6);
        }
        if (IN(pb + 7)) { PHASE_BEGIN();
            pg8::Gemm g{HB, nullptr, Wmrg, D, T, 4096, D, 1 << 20, 0}; pg8::StaticOrder S; S.init(T, 4096, F.G, (int)blockIdx.x);
            pg8::EpiMerge E{MG, PJ, R1};
            pg8::gemm_phase<pg8::EpiMerge, pg8::StaticOrder, true, true>(F.lds + RING_OFF, g, S, E);
            SEAM(pb + 7);
        }
        if (IN(pb + 8)) { PHASE_BEGIN();
            pg8::Gemm g{MG, nullptr, Wout, D, T, D, D, 1 << 20, 0}; pg8::StaticOrder S; S.init(T, D, F.G, (int)blockIdx.x);
            pg8::EpiResF32 E{HB, D, SS16, nullptr};
            pg8::gemm_phase<pg8::EpiResF32, pg8::StaticOrder, true, true>(F.lds + RING_OFF, g, S, E);
            SEAM(pb + 8);
        }
        if (IN(pb + 9)) { PHASE_BEGIN();
            pg8::Gemm g{HB, nullptr, Wxq, D, T, D, D, 1 << 20, 0}; pg8::StaticOrder S; S.init(T, D, F.G, (int)blockIdx.x);
            { pg8::EpiBf16<0> E{XQ, D, 1.f, nullptr, nullptr, nullptr};
              pg8::gemm_phase<pg8::EpiBf16<0>, pg8::StaticOrder, true, true>(F.lds + RING_OFF, g, S, E); }
            PHASE_BEGIN();
            __syncthreads();
            { pg8::Unit u; for (int i = 0; S.next(i, u); ++i) xattn_unit(F.lds + RING_OFF, u.pm >> 4, u.pn, u.pm & 15, F.tid, XQ, KX, VX, XO, SS16); }
            SEAM(pb + 9);
        }
        if (IN(pb + 11)) { PHASE_BEGIN();
            pg8::Gemm g{XO, nullptr, Wxo, D, T, D, D, 1 << 20, 0}; pg8::StaticOrder S; S.init(T, D, F.G, (int)blockIdx.x);
            pg8::EpiResF32 E{HB, D, SS16B, nullptr};
            pg8::gemm_phase<pg8::EpiResF32, pg8::StaticOrder, true, true>(F.lds + RING_OFF, g, S, E);
            SEAM(pb + 11);
        }
        if (IN(pb + 13)) { PHASE_BEGIN();
            pg8::Gemm g{HB, nullptr, Wup, D, T, FF, D, 1 << 20, 0}; pg8::StaticOrder S; S.init(T, FF, F.G, (int)blockIdx.x);
            pg8::EpiBf16<2> E{HID, FF, 1.f, nullptr, SS16B, R1};
            pg8::gemm_phase<pg8::EpiBf16<2>, pg8::StaticOrder, true, true>(F.lds + RING_OFF, g, S, E);
            SEAM(pb + 13);
        }
        if (IN(pb + 14)) { PHASE_BEGIN();
            pg8::Gemm g{HID, nullptr, Wdn, FF, T, D, FF, 1 << 20, 0}; pg8::StaticOrder S; S.init(T, D, F.G, (int)blockIdx.x);
            pg8::EpiResF32 E{HB, D, SS16, R1};
            pg8::gemm_phase<pg8::EpiResF32, pg8::StaticOrder, true, true>(F.lds + RING_OFF, g, S, E);
            SEAM(pb + 14);
        }
    }
    if (IN(DEPTH * NPH_L)) { PHASE_BEGIN();
        const GAS f32x4* gr = (const GAS f32x4*)norm_final + F.lane; f32x4 gg[4];
#pragma unroll
        for (int j = 0; j < 4; ++j) gg[j] = gr[64 * j];
        for (int m = 4 * gw; m < T; m += 4 * NGW) {
            float r[4]; unsigned long long w[4][4];
#pragma unroll
            for (int q = 0; q < 4; ++q) { const int mq = (m + q < T) ? m + q : m; r[q] = row_rscale(SS16, (size_t)mq); const GAS unsigned long long* xr = (const GAS unsigned long long*)(HB + (size_t)mq * D) + F.lane;
#pragma unroll
                for (int j = 0; j < 4; ++j) w[q][j] = xr[64 * j]; }
#pragma unroll
            for (int q = 0; q < 4; ++q) if (m + q < T) { GAS f32x4* orow = (GAS f32x4*)(XR + (size_t)(m + q) * D) + F.lane;
#pragma unroll
                for (int j = 0; j < 4; ++j) { const unsigned lo = (unsigned)w[q][j], hi = (unsigned)(w[q][j] >> 32);
                    orow[64 * j] = (f32x4){bflo(lo) * r[q] * gg[j].x, bfhi(lo) * r[q] * gg[j].y, bflo(hi) * r[q] * gg[j].z, bfhi(hi) * r[q] * gg[j].w}; } } }
    }
#undef IN
#undef SEAM
}

extern "C" void kernel_launch(void* const* d_in, const int* in_sizes, int n_in, void* d_out, int out_size, void* d_ws, size_t ws_size, hipStream_t stream) {
    static int grid = 0;
    if (grid == 0) {
        if (n_in != 32 || out_size != T * D || ws_size < WS_END) { fprintf(stderr, "kernel_launch: unexpected shapes (n_in %d, out %d, ws %zu)\n", n_in, out_size, ws_size); grid = -1; return; }
        int dev = 0, cus = 0, per_cu = 0;
        if (hipGetDevice(&dev) != hipSuccess || hipDeviceGetAttribute(&cus, hipDeviceAttributeMultiprocessorCount, dev) != hipSuccess) { grid = -1; return; }
        if (hipFuncSetAttribute((const void*)skel_fwd, hipFuncAttributeMaxDynamicSharedMemorySize, LDS_BYTES) != hipSuccess) { fprintf(stderr, "kernel_launch: hipFuncSetAttribute failed\n"); grid = -1; return; }
        if (hipOccupancyMaxActiveBlocksPerMultiprocessor(&per_cu, (const void*)skel_fwd, NWAVES * 64, LDS_BYTES) != hipSuccess || per_cu < 1)
            fprintf(stderr, "kernel_launch: occupancy query reports %d workgroups per CU\n", per_cu);
        (void)hipGetLastError();
        grid = cus;
        if (grid > 256) grid = 256;
    }
    if (grid < 0) return;
    if (hipMemsetAsync((char*)d_ws + WS_CTL, 0, CTL_ZERO_BYTES, stream) != hipSuccess) return;
    Args a{};
    for (int i = 0; i < 32; ++i) a.in[i] = d_in[i];
    a.out = (float*)d_out; a.ws = (unsigned char*)d_ws;
#if MK_N_LAUNCHES == 1
    a.ph_lo = 0; a.ph_hi = NPHASES;
    hipLaunchKernelGGL(skel_fwd, dim3(grid), dim3(NWAVES * 64), LDS_BYTES, stream, a);
#else
    for (int p = 0; p < NPHASES; ++p) { a.ph_lo = p; a.ph_hi = p + 1; hipLaunchKernelGGL(skel_fwd, dim3(grid), dim3(NWAVES * 64), LDS_BYTES, stream, a); }
#endif
}
```

```cpp
#include <hip/hip_runtime.h>
#include <cstdio>
#include <cstdint>

namespace pg8 {
#define PG8_LAS __attribute__((address_space(3)))
typedef unsigned short bf16_t;
typedef short bf16x8 __attribute__((ext_vector_type(8)));
typedef float f32x4 __attribute__((ext_vector_type(4)));
typedef unsigned u32x4 __attribute__((ext_vector_type(4)));
typedef unsigned u32x2 __attribute__((ext_vector_type(2)));
constexpr int BM = 256, BK = 64, HALF = 128, HTB = HALF * BK * 2, STAGE_BYTES = 8 * HTB, NXCD = 8, WGM = 8;

__host__ __device__ __forceinline__ int lds_byte(int r, int c) { const int st = (r >> 4) * 2 + (c >> 5), rr = r & 15, cc = c & 31, ob = rr * 64 + cc * 2; return st * 1024 + (ob ^ (((ob >> 9) & 1) << 5)); }
__host__ __device__ __forceinline__ void stage_rc(int b, int& R, int& C) { const int st = b / 1024, sb = b % 1024, swz = sb ^ (((sb >> 9) & 1) << 5); R = (st >> 1) * 16 + swz / 64; C = (st & 1) * 32 + (swz % 64) / 2; }
__host__ __device__ __forceinline__ int perm32(int rho) { const int n = rho >> 4, i = rho & 15; return 8 * (i >> 2) + 4 * n + (i & 3); }

struct Unit { int pm, pn; };
struct Gemm { const bf16_t* A; const bf16_t* A2; const bf16_t* Bt; int lda; int M, N, K; int ksplit; int agrp; };

struct StaticOrder {
    int nM, nN, nwg, G, c;
    __host__ __device__ __forceinline__ void init(int M, int N, int G_, int c_) { nM = M / BM; nN = N / BM; nwg = nM * nN; G = G_; c = c_; }
    __host__ __device__ __forceinline__ bool next(int i, Unit& u) const {
        const long L = (long)i * G + c; if (L >= nwg) return false;
        int wgid = (int)L; { const int q = nwg / NXCD, r = nwg % NXCD, xcd = wgid % NXCD, off = wgid / NXCD; wgid = (xcd < r ? xcd * (q + 1) : r * (q + 1) + (xcd - r) * q) + off; }
        const int nig = WGM * nN, gid = wgid / nig, fm = gid * WGM, gsz = (nM - fm) < WGM ? (nM - fm) : WGM;
        u.pm = fm + ((wgid % nig) % gsz); u.pn = (wgid % nig) / gsz; return true;
    }
    __device__ __forceinline__ void a_ready(const Unit&) const {}
    __device__ __forceinline__ void done(const Unit&) const {}
};

typedef float f32x2_t __attribute__((ext_vector_type(2))); typedef __bf16 bf16x2_t __attribute__((ext_vector_type(2)));
__device__ __forceinline__ unsigned cvt_pk_bf16(float lo, float hi) { f32x2_t v = {lo, hi}; bf16x2_t b = __builtin_convertvector(v, bf16x2_t); return __builtin_bit_cast(unsigned, b); }

__device__ __forceinline__ float row_rscale(const float* ss, size_t row) { const f32x4 a = *(const f32x4*)(ss + row * 16), b = *(const f32x4*)(ss + row * 16 + 4), c = *(const f32x4*)(ss + row * 16 + 8), d = *(const f32x4*)(ss + row * 16 + 12);
    const float t = ((a[0] + a[1]) + (a[2] + a[3])) + ((b[0] + b[1]) + (b[2] + b[3])) + ((c[0] + c[1]) + (c[2] + c[3])) + ((d[0] + d[1]) + (d[2] + d[3])); return 1.0f / sqrtf(t * (1.f / 1024.f) + 1e-6f); }
__device__ __forceinline__ void row_rscale8(const float* ss, int row0, int fq, float (&r)[8]) {
    f32x4 p[8];
#pragma unroll
    for (int i = 0; i < 8; ++i) p[i] = *(const f32x4*)(ss + (size_t)(row0 + (i >> 2) * HALF + (i & 3) * 16) * 16 + 4 * fq);
#pragma unroll
    for (int i = 0; i < 8; ++i) { float t = (p[i][0] + p[i][1]) + (p[i][2] + p[i][3]); t += __shfl_xor(t, 16); t += __shfl_xor(t, 32); r[i] = 1.0f / sqrtf(t * (1.f / 1024.f) + 1e-6f); }
}
template <int ACT> struct EpiBf16 {
    static constexpr bool PERM = true, AFTER_DRAIN = false, HAS_MID = false;
    bf16_t* O; int ldc; float scale; const float* ss; const float* rsrc; float* rout;
    __device__ __forceinline__ void mid(f32x4 (&)[2][2][4][2], const Unit&, int, int, int, int) const {}
    __device__ __forceinline__ void operator()(const f32x4 (&acc)[2][2][4][2], const Unit& u, int wr, int wc, int fr, int fq) const {
        { int t_ = threadIdx.x; asm volatile("" : "+v"(t_)); fr = t_ & 15; fq = (t_ >> 4) & 3; }
        const int row0 = u.pm * BM + wr * 64 + fr; const int col0 = u.pn * BM + wc * 32 + 8 * fq;
        float rs8[8];
        if (rout && u.pn == 0 && wc == 0) { row_rscale8(rsrc, row0, fq, rs8);
            if (fq == 0) {
#pragma unroll
                for (int i = 0; i < 8; ++i) rout[row0 + (i >> 2) * HALF + (i & 3) * 16] = rs8[i]; } }
        if (ss) { row_rscale8(ss, row0, fq, rs8);
#pragma unroll
            for (int i = 0; i < 8; ++i) rs8[i] = scale * ((ACT == 2) ? rs8[i] * rs8[i] : rs8[i]); }
        else {
#pragma unroll
            for (int i = 0; i < 8; ++i) rs8[i] = scale; }
#pragma unroll
        for (int ai = 0; ai < 2; ++ai)
#pragma unroll
            for (int m = 0; m < 4; ++m) { const size_t row = (size_t)(row0 + ai * HALF + m * 16); bf16_t* rowp = O + row * ldc + col0;
                const float rs = rs8[ai * 4 + m];
#pragma unroll
                for (int bj = 0; bj < 2; ++bj) { f32x4 v0 = acc[ai][bj][m][0], v1 = acc[ai][bj][m][1];
                    if (ACT == 2) {
#pragma unroll
                        for (int j = 0; j < 4; ++j) { float a = v0[j] > 0.f ? v0[j] : 0.f; v0[j] = a * a; float b = v1[j] > 0.f ? v1[j] : 0.f; v1[j] = b * b; } }
                    v0 = v0 * rs; v1 = v1 * rs; u32x4 w; w.x = cvt_pk_bf16(v0[0], v0[1]); w.y = cvt_pk_bf16(v0[2], v0[3]); w.z = cvt_pk_bf16(v1[0], v1[1]); w.w = cvt_pk_bf16(v1[2], v1[3]);
                    *(u32x4*)(rowp + bj * HALF) = w; } }
    }
};
struct EpiZin {
    static constexpr bool PERM = true, AFTER_DRAIN = false, HAS_MID = false;
    bf16_t* ZA; bf16_t* ZB; float* SSQ; float* ZF; const float* ss;
    __device__ __forceinline__ void mid(f32x4 (&)[2][2][4][2], const Unit&, int, int, int, int) const {}
    __device__ __forceinline__ void operator()(const f32x4 (&acc)[2][2][4][2], const Unit& u, int wr, int wc, int fr, int fq) const {
        { int t_ = threadIdx.x; asm volatile("" : "+v"(t_)); fr = t_ & 15; fq = (t_ >> 4) & 3; }
        const int row0 = u.pm * BM + wr * 64 + fr; const int pn = u.pn;
        bf16_t* base = (pn < 4) ? ZA + pn * BM : ZB + (pn - 4) * BM; const int ldc = (pn < 4) ? 1024 : 1792;
        const int col0 = wc * 32 + 8 * fq;
        float rr8[8];
#pragma unroll
        for (int i = 0; i < 8; ++i) rr8[i] = ss[row0 + (i >> 2) * HALF + (i & 3) * 16];
#pragma unroll
        for (int ai = 0; ai < 2; ++ai)
#pragma unroll
            for (int m = 0; m < 4; ++m) { const int row = row0 + ai * HALF + m * 16; bf16_t* rowp = base + (size_t)row * ldc + col0; const float rr = rr8[ai * 4 + m];
#pragma unroll
                for (int bj = 0; bj < 2; ++bj) { const f32x4 v0 = acc[ai][bj][m][0] * rr, v1 = acc[ai][bj][m][1] * rr;
                    u32x4 w; w.x = cvt_pk_bf16(v0[0], v0[1]); w.y = cvt_pk_bf16(v0[2], v0[3]); w.z = cvt_pk_bf16(v1[0], v1[1]); w.w = cvt_pk_bf16(v1[2], v1[3]);
                    *(u32x4*)(rowp + bj * HALF) = w; }
                if (pn <= 1) { float s = 0.f;
#pragma unroll
                    for (int bj = 0; bj < 2; ++bj) if (bj == 0 || pn == 0) {
#pragma unroll
                        for (int n = 0; n < 2; ++n) { const f32x4 x = acc[ai][bj][m][n] * rr; s += (x[0] * x[0] + x[1] * x[1]) + (x[2] * x[2] + x[3] * x[3]); } }
                    s += __shfl_xor(s, 16); s += __shfl_xor(s, 32);
                    if (fq == 0) SSQ[(size_t)row * 8 + pn * 4 + wc] = s;
                    if (pn == 1 && wc == 1) { float* zf = ZF + (size_t)row * 32 + 8 * fq; *(f32x4*)zf = acc[ai][1][m][0] * rr; *(f32x4*)(zf + 4) = acc[ai][1][m][1] * rr; } }
            }
    }
};
struct EpiMla {
    static constexpr bool PERM = true, AFTER_DRAIN = false, HAS_MID = false;
    bf16_t* Q; bf16_t* K; bf16_t* V; const float* SSQ; const float* RC; const float* RS;
    __device__ __forceinline__ void mid(f32x4 (&)[2][2][4][2], const Unit&, int, int, int, int) const {}
    __device__ __forceinline__ void operator()(const f32x4 (&acc)[2][2][4][2], const Unit& u, int wr, int wc, int fr, int fq) const {
        { int t_ = threadIdx.x; asm volatile("" : "+v"(t_)); fr = t_ & 15; fq = (t_ >> 4) & 3; }
        const int row0 = u.pm * BM + wr * 64 + fr;
        float rq8[8], rkv8[8];
#pragma unroll
        for (int i = 0; i < 8; ++i) { const size_t t = (size_t)(row0 + (i >> 2) * HALF + (i & 3) * 16); rq8[i] = SSQ[t * 8 + fq]; rkv8[i] = SSQ[t * 8 + 4 + fq]; }
#pragma unroll
        for (int i = 0; i < 8; ++i) { float a = rq8[i], b2 = rkv8[i]; a += __shfl_xor(a, 16); b2 += __shfl_xor(b2, 16); a += __shfl_xor(a, 32); b2 += __shfl_xor(b2, 32);
            rq8[i] = 1.0f / sqrtf(a * (1.f / 256.f) + 1e-6f); rkv8[i] = 1.0f / sqrtf(b2 * (1.f / 128.f) + 1e-6f); }
        bool rope = false;
#pragma unroll
        for (int bj = 0; bj < 2; ++bj) { const int c32 = u.pn * BM + bj * HALF + wc * 32; rope = rope || (c32 < 384 ? (c32 % 96 == 64) : (c32 >= 896 && c32 < 928)); }
#pragma unroll
        for (int ai = 0; ai < 2; ++ai) {
            f32x4 cs4[4], sn4[4];
            if (rope) {
#pragma unroll
                for (int m = 0; m < 4; ++m) { const size_t t = (size_t)(row0 + ai * HALF + m * 16); cs4[m] = *(const f32x4*)(RC + t * 16 + 4 * fq); sn4[m] = *(const f32x4*)(RS + t * 16 + 4 * fq); } }
            else {
#pragma unroll
                for (int m = 0; m < 4; ++m) { cs4[m] = (f32x4){0.f, 0.f, 0.f, 0.f}; sn4[m] = cs4[m]; } }
#pragma unroll
            for (int m = 0; m < 4; ++m) { const size_t t = (size_t)(row0 + ai * HALF + m * 16);
                const float rq = rq8[ai * 4 + m], rkv = rkv8[ai * 4 + m];
#pragma unroll
                for (int bj = 0; bj < 2; ++bj) { const int c32 = u.pn * BM + bj * HALF + wc * 32;
                    const int c8 = c32 + 8 * fq; const f32x4 v0 = acc[ai][bj][m][0], v1 = acc[ai][bj][m][1];
                    if (c32 < 384) { const int h = c32 / 96, o32 = c32 - 96 * h;
                        if (o32 < 64) { const f32x4 a = v0 * rq, b = v1 * rq; u32x4 w; w.x = cvt_pk_bf16(a[0], a[1]); w.y = cvt_pk_bf16(a[2], a[3]); w.z = cvt_pk_bf16(b[0], b[1]); w.w = cvt_pk_bf16(b[2], b[3]);
                            *(u32x4*)(Q + t * 384 + c8) = w; }
                        else { const int jp = 4 * fq; const f32x4 cs = cs4[m], sn = sn4[m];
                            const float x10 = v0[0] * rq, x20 = v0[1] * rq, x11 = v0[2] * rq, x21 = v0[3] * rq, x12 = v1[0] * rq, x22 = v1[1] * rq, x13 = v1[2] * rq, x23 = v1[3] * rq;
                            u32x2 y1, y2; y1.x = cvt_pk_bf16(x10 * cs[0] - x20 * sn[0], x11 * cs[1] - x21 * sn[1]); y1.y = cvt_pk_bf16(x12 * cs[2] - x22 * sn[2], x13 * cs[3] - x23 * sn[3]);
                            y2.x = cvt_pk_bf16(x20 * cs[0] + x10 * sn[0], x21 * cs[1] + x11 * sn[1]); y2.y = cvt_pk_bf16(x22 * cs[2] + x12 * sn[2], x23 * cs[3] + x13 * sn[3]);
                            *(u32x2*)(Q + t * 384 + h * 96 + 64 + jp) = y1; *(u32x2*)(Q + t * 384 + h * 96 + 80 + jp) = y2; } }
                    else if (c32 < 896) { const int c = c8 - 384, h = c >> 7, o = c & 127; const f32x4 a = v0 * rkv, b = v1 * rkv;
                        u32x4 w; w.x = cvt_pk_bf16(a[0], a[1]); w.y = cvt_pk_bf16(a[2], a[3]); w.z = cvt_pk_bf16(b[0], b[1]); w.w = cvt_pk_bf16(b[2], b[3]);
                        if (o < 64) *(u32x4*)(K + t * 384 + h * 96 + o) = w;
                        else { bf16_t* vt = V + ((size_t)((t >> 12) * 4 + h) * 64 + (o - 64)) * 4096 + (t & 4095);
                            vt[0] = (bf16_t)w.x; vt[4096] = (bf16_t)(w.x >> 16); vt[2 * 4096] = (bf16_t)w.y; vt[3 * 4096] = (bf16_t)(w.y >> 16);
                            vt[4 * 4096] = (bf16_t)w.z; vt[5 * 4096] = (bf16_t)(w.z >> 16); vt[6 * 4096] = (bf16_t)w.w; vt[7 * 4096] = (bf16_t)(w.w >> 16); } }
                    else if (c32 < 928) { const int jp = 4 * fq; const f32x4 cs = cs4[m], sn = sn4[m];
                        u32x2 y1, y2; y1.x = cvt_pk_bf16(v0[0] * cs[0] - v0[1] * sn[0], v0[2] * cs[1] - v0[3] * sn[1]); y1.y = cvt_pk_bf16(v1[0] * cs[2] - v1[1] * sn[2], v1[2] * cs[3] - v1[3] * sn[3]);
                        y2.x = cvt_pk_bf16(v0[1] * cs[0] + v0[0] * sn[0], v0[3] * cs[1] + v0[2] * sn[1]); y2.y = cvt_pk_bf16(v1[1] * cs[2] + v1[0] * sn[2], v1[3] * cs[3] + v1[2] * sn[3]);
#pragma unroll
                        for (int h2 = 0; h2 < 4; ++h2) { *(u32x2*)(K + t * 384 + h2 * 96 + 64 + jp) = y1; *(u32x2*)(K + t * 384 + h2 * 96 + 80 + jp) = y2; } }
                }
            }
        }
    }
};
struct EpiBf16T {
    static constexpr bool PERM = true, AFTER_DRAIN = false, HAS_MID = false;
    bf16_t* O;
    __device__ __forceinline__ void mid(f32x4 (&)[2][2][4][2], const Unit&, int, int, int, int) const {}
    __device__ __forceinline__ void operator()(const f32x4 (&acc)[2][2][4][2], const Unit& u, int wr, int wc, int fr, int fq) const {
        const int row0 = u.pm * BM + wr * 64 + fr; const int col0 = u.pn * BM + wc * 32 + 8 * fq;
#pragma unroll
        for (int ai = 0; ai < 2; ++ai)
#pragma unroll
            for (int m = 0; m < 4; ++m) { const int row = row0 + ai * HALF + m * 16; bf16_t* bp = O + ((size_t)(row >> 8) * 1024 + col0) * 256 + (row & 255);
#pragma unroll
                for (int bj = 0; bj < 2; ++bj) { const f32x4 v0 = acc[ai][bj][m][0], v1 = acc[ai][bj][m][1]; bf16_t* p = bp + (size_t)(bj * HALF) * 256;
                    const unsigned w0 = cvt_pk_bf16(v0[0], v0[1]), w1 = cvt_pk_bf16(v0[2], v0[3]), w2 = cvt_pk_bf16(v1[0], v1[1]), w3 = cvt_pk_bf16(v1[2], v1[3]);
                    p[0] = (bf16_t)w0; p[256] = (bf16_t)(w0 >> 16); p[512] = (bf16_t)w1; p[768] = (bf16_t)(w1 >> 16); p[1024] = (bf16_t)w2; p[1280] = (bf16_t)(w2 >> 16); p[1536] = (bf16_t)w3; p[1792] = (bf16_t)(w3 >> 16); } }
    }
};
struct EpiResF32 {
    static constexpr bool PERM = true, AFTER_DRAIN = false, HAS_MID = false;
    bf16_t* xb; int ldc; float* ss; const float* ssin;
    __device__ __forceinline__ void mid(f32x4 (&)[2][2][4][2], const Unit&, int, int, int, int) const {}
    __device__ __forceinline__ void operator()(const f32x4 (&acc)[2][2][4][2], const Unit& u, int wr, int wc, int fr, int fq) const {
        { int t_ = threadIdx.x; asm volatile("" : "+v"(t_)); fr = t_ & 15; fq = (t_ >> 4) & 3; }
        const int row0 = u.pm * BM + wr * 64 + fr, col0 = u.pn * BM + wc * 32 + 8 * fq;
        float r28[8];
        if (ssin) {
#pragma unroll
            for (int i = 0; i < 8; ++i) { const float r = ssin[row0 + (i >> 2) * HALF + (i & 3) * 16]; r28[i] = r * r; } }
        else {
#pragma unroll
            for (int i = 0; i < 8; ++i) r28[i] = 1.f; }
        u32x4 xo8[8][2];
#pragma unroll
        for (int i = 0; i < 8; ++i) { const size_t off = (size_t)(row0 + (i >> 2) * HALF + (i & 3) * 16) * ldc + col0; xo8[i][0] = *(const u32x4*)(xb + off); xo8[i][1] = *(const u32x4*)(xb + off + HALF); }
#pragma unroll
        for (int ai = 0; ai < 2; ++ai)
#pragma unroll
            for (int m = 0; m < 4; ++m) { const size_t row = (size_t)(row0 + ai * HALF + m * 16); const size_t off = row * ldc + col0; float sq = 0.f; const float r2 = r28[ai * 4 + m];
#pragma unroll
                for (int bj = 0; bj < 2; ++bj) { const u32x4 xo = xo8[ai * 4 + m][bj];
                    f32x4 r0, r1; r0[0] = __uint_as_float(xo.x << 16); r0[1] = __uint_as_float(xo.x & 0xffff0000u); r0[2] = __uint_as_float(xo.y << 16); r0[3] = __uint_as_float(xo.y & 0xffff0000u);
                    r1[0] = __uint_as_float(xo.z << 16); r1[1] = __uint_as_float(xo.z & 0xffff0000u); r1[2] = __uint_as_float(xo.w << 16); r1[3] = __uint_as_float(xo.w & 0xffff0000u);
                    r0 += acc[ai][bj][m][0] * r2; r1 += acc[ai][bj][m][1] * r2;
                    u32x4 w; w.x = cvt_pk_bf16(r0[0], r0[1]); w.y = cvt_pk_bf16(r0[2], r0[3]); w.z = cvt_pk_bf16(r1[0], r1[1]); w.w = cvt_pk_bf16(r1[2], r1[3]); *(u32x4*)(xb + off + bj * HALF) = w;
                    const float q0 = __uint_as_float(w.x << 16), q1 = __uint_as_float(w.x & 0xffff0000u), q2 = __uint_as_float(w.y << 16), q3 = __uint_as_float(w.y & 0xffff0000u), q4 = __uint_as_float(w.z << 16), q5 = __uint_as_float(w.z & 0xffff0000u), q6 = __uint_as_float(w.w << 16), q7 = __uint_as_float(w.w & 0xffff0000u);
                    sq += ((q0 * q0 + q1 * q1) + (q2 * q2 + q3 * q3)) + ((q4 * q4 + q5 * q5) + (q6 * q6 + q7 * q7)); }
                sq += __shfl_xor(sq, 16); sq += __shfl_xor(sq, 32);
                if (fq == 0) ss[row * 16 + u.pn * 4 + wc] = sq; }
    }
};
struct EpiMerge {
    static constexpr bool PERM = false, AFTER_DRAIN = false, HAS_MID = false;
    bf16_t* MG; const bf16_t* P; const float* r1;
    __device__ __forceinline__ void mid(f32x4 (&)[2][2][4][2], const Unit&, int, int, int, int) const {}
    __device__ __forceinline__ void operator()(const f32x4 (&acc)[2][2][4][2], const Unit& u, int wr, int wc, int fr, int fq) const {
        { int t_ = threadIdx.x; asm volatile("" : "+v"(t_)); fr = t_ & 15; fq = (t_ >> 4) & 3; }
        const int row0 = u.pm * BM + wr * 64 + fr, col0 = u.pn * 64 + wc * 16 + 4 * fq;
        u32x2 pw8[8][4]; float rr8[8];
#pragma unroll
        for (int i = 0; i < 8; ++i) { const size_t row = (size_t)(row0 + (i >> 2) * HALF + (i & 3) * 16); rr8[i] = r1[row]; const bf16_t* pp = P + ((((size_t)(row >> 6) * 4) * 128 + (col0 >> 3)) * 64 + (row & 63)) * 8 + (col0 & 4);
#pragma unroll
            for (int gte = 0; gte < 4; ++gte) pw8[i][gte] = *(const u32x2*)(pp + (size_t)gte * 128 * 64 * 8); }
#pragma unroll
        for (int ai = 0; ai < 2; ++ai)
#pragma unroll
            for (int m = 0; m < 4; ++m) { const size_t row = (size_t)(row0 + ai * HALF + m * 16); const float rr = rr8[ai * 4 + m]; const u32x2* pw = pw8[ai * 4 + m];
                f32x4 sum = (f32x4){0.f, 0.f, 0.f, 0.f};
#pragma unroll
                for (int bj = 0; bj < 2; ++bj)
#pragma unroll
                    for (int n = 0; n < 2; ++n) { const f32x4 v = acc[ai][bj][m][n]; const u32x2 w = pw[2 * bj + n]; f32x4 p;
                        p[0] = __uint_as_float(w.x << 16); p[1] = __uint_as_float(w.x & 0xffff0000u); p[2] = __uint_as_float(w.y << 16); p[3] = __uint_as_float(w.y & 0xffff0000u);
#pragma unroll
                        for (int j = 0; j < 4; ++j) sum[j] += __builtin_amdgcn_rcpf(1.0f + __expf(-v[j] * rr)) * p[j]; }
                u32x2 o; o.x = cvt_pk_bf16(sum[0], sum[1]); o.y = cvt_pk_bf16(sum[2], sum[3]);
                *(u32x2*)(MG + row * 1024 + col0) = o; }
    }
};

template <class Epi, class Sched, bool ALIGN_EPI = false, bool SP2 = false>
__device__ __forceinline__ void gemm_phase(PG8_LAS unsigned char* lds, const Gemm g, const Sched& S, const Epi& E) {
    int tid = threadIdx.x; asm volatile("" : "+v"(tid)); const int wid = __builtin_amdgcn_readfirstlane(tid >> 6), lane = tid & 63, wr = wid >> 2, wc = wid & 3, fr = lane & 15, fq = lane >> 4;
    const int K = g.K, nt = K / BK, lda = g.lda, ksplit = g.ksplit;
    unsigned voffA[2], voffB[2];
#pragma unroll
    for (int i = 0; i < 2; ++i) { int R, C; stage_rc(tid * 16 + i * 8192, R, C); const int Rb = Epi::PERM ? ((R & ~31) + perm32(R & 31)) : R;
        voffA[i] = (unsigned)(R * lda + C) * 2u; voffB[i] = (unsigned)(Rb * K + C) * 2u; }
    const size_t kstep = (size_t)(BK * 2);
    const size_t hstepA = (size_t)HALF * lda * 2, tstepA = 2 * hstepA;
    const size_t hstepB = (size_t)HALF * K * 2, tstepB = 2 * hstepB;
    const long dA2 = g.A2 ? (long)((const char*)g.A2 - (const char*)g.A) - (long)ksplit * (long)kstep : 0L;
    const unsigned ldsw = (unsigned)wid * 1024u;
    const int aoff = lds_byte(wr * 64 + fr, fq * 8), boff = lds_byte(wc * 32 + fr, fq * 8);
#define PG8_SA(b, h) (((b) * 2 + (h)) * HTB)
#define PG8_SB(b, h) ((4 + (b) * 2 + (h)) * HTB)
#define PG8_STAGE(bufoff, gbase, voff) do { _Pragma("unroll") for (int _i = 0; _i < 2; ++_i) \
        __builtin_amdgcn_global_load_lds((const unsigned*)((const char*)(gbase) + (voff)[_i]), (PG8_LAS unsigned*)(lds + (bufoff) + ldsw + _i * 8192), 16, 0, 0); } while (0)
#define PG8_LDA(dst, b, h) do { _Pragma("unroll") for (int m = 0; m < 4; ++m) _Pragma("unroll") for (int k = 0; k < 2; ++k) dst[m][k] = *(const PG8_LAS bf16x8*)(lds + PG8_SA(b, h) + aoff + m * 2048 + k * 1024); } while (0)
#define PG8_LDB(dst, b, h) do { _Pragma("unroll") for (int n = 0; n < 2; ++n) _Pragma("unroll") for (int k = 0; k < 2; ++k) dst[n][k] = *(const PG8_LAS bf16x8*)(lds + PG8_SB(b, h) + boff + n * 2048 + k * 1024); } while (0)
#define PG8_MMA(ai, bj, At, Bt) do { __builtin_amdgcn_s_setprio(1); _Pragma("unroll") for (int m = 0; m < 4; ++m) _Pragma("unroll") for (int n = 0; n < 2; ++n) _Pragma("unroll") for (int k = 0; k < 2; ++k) \
        acc[ai][bj][m][n] = __builtin_amdgcn_mfma_f32_16x16x32_bf16(Bt[n][k], At[m][k], acc[ai][bj][m][n], 0, 0, 0); __builtin_amdgcn_s_setprio(0); } while (0)
#define PG8_MMAM(ai, bj, At, Bt) do { if constexpr (!Epi::HAS_MID) { PG8_MMA(ai, bj, At, Bt); } else { const bool e0 = (pgate < 0) || (pgate == 2 * (bj)), e1 = (pgate < 0) || (pgate == 2 * (bj) + 1); \
        __builtin_amdgcn_s_setprio(1); if (e0) { _Pragma("unroll") for (int m = 0; m < 4; ++m) _Pragma("unroll") for (int k = 0; k < 2; ++k) acc[ai][bj][m][0] = __builtin_amdgcn_mfma_f32_16x16x32_bf16(Bt[0][k], At[m][k], acc[ai][bj][m][0], 0, 0, 0); } \
        if (e1) { _Pragma("unroll") for (int m = 0; m < 4; ++m) _Pragma("unroll") for (int k = 0; k < 2; ++k) acc[ai][bj][m][1] = __builtin_amdgcn_mfma_f32_16x16x32_bf16(Bt[1][k], At[m][k], acc[ai][bj][m][1], 0, 0, 0); } __builtin_amdgcn_s_setprio(0); } } while (0)
#define PG8_WAIT_V(n) asm volatile("s_waitcnt vmcnt(" #n ")" ::: "memory")
#define PG8_WAIT_L(n) asm volatile("s_waitcnt lgkmcnt(" #n ")" ::: "memory")
#define PG8_BAR __builtin_amdgcn_s_barrier()
#define PG8_SCHED __builtin_amdgcn_sched_barrier(0)
#define PG8_AT(base, tt) ((base) + (size_t)(tt) * kstep + (((tt) >= ksplit) ? dA2 : 0L))
    Unit cur, nxt; int ui = 0;
    if (!S.next(0, cur)) return;
    f32x4 acc[2][2][4][2];
#pragma unroll
    for (int a = 0; a < 2; ++a)
#pragma unroll
        for (int b = 0; b < 2; ++b)
#pragma unroll
            for (int m = 0; m < 4; ++m)
#pragma unroll
                for (int n = 0; n < 2; ++n) acc[a][b][m][n] = (f32x4){0.f, 0.f, 0.f, 0.f};
    bf16x8 At[4][2], B0[2][2], B1[2][2];
    const char* cA = (const char*)g.A + (size_t)cur.pm * tstepA + (size_t)(cur.pn >> 2) * g.agrp; const char* cB = (const char*)g.Bt + (size_t)cur.pn * tstepB;
    S.a_ready(cur);
    if constexpr (SP2) {
        PG8_STAGE(PG8_SB(0, 0), cB, voffB); PG8_STAGE(PG8_SB(0, 1), cB + hstepB, voffB); PG8_STAGE(PG8_SA(0, 0), cA, voffA); PG8_STAGE(PG8_SA(0, 1), cA + hstepA, voffA);
        if (wr == 1) PG8_BAR;
        PG8_WAIT_V(2); PG8_BAR;
        PG8_STAGE(PG8_SB(1, 0), cB + kstep, voffB); PG8_STAGE(PG8_SA(1, 0), cA + kstep, voffA); PG8_STAGE(PG8_SB(1, 1), cB + hstepB + kstep, voffB);
        PG8_WAIT_V(6); PG8_BAR;
    } else {
        PG8_STAGE(PG8_SB(0, 0), cB, voffB); PG8_STAGE(PG8_SA(0, 0), cA, voffA); PG8_STAGE(PG8_SB(0, 1), cB + hstepB, voffB); PG8_STAGE(PG8_SA(0, 1), cA + hstepA, voffA);
        if (wr == 1) PG8_BAR;
        PG8_WAIT_V(4); PG8_BAR;
        PG8_STAGE(PG8_SB(1, 0), cB + kstep, voffB); PG8_STAGE(PG8_SA(1, 0), cA + kstep, voffA); PG8_STAGE(PG8_SB(1, 1), cB + hstepB + kstep, voffB);
        PG8_WAIT_V(6); PG8_BAR;
    }
    for (;;) {
        const bool has_next = S.next(ui + 1, nxt);
        const char* nA = has_next ? (const char*)g.A + (size_t)nxt.pm * tstepA + (size_t)(nxt.pn >> 2) * g.agrp : cA; const char* nB = has_next ? (const char*)g.Bt + (size_t)nxt.pn * tstepB : cB;
        for (int t = 0; t < nt; t += 2) {
            const bool last = (t == nt - 2);
            if constexpr (Epi::HAS_MID) { if (t == ksplit) E.mid(acc, cur, wr, wc, fr, fq); }
            const char* a1 = PG8_AT(cA, t + 1);
            const char* a2 = last ? nA : PG8_AT(cA, t + 2); const char* b2 = last ? nB : cB + (size_t)(t + 2) * kstep;
            const char* a3 = last ? nA + kstep : PG8_AT(cA, t + 3); const char* b3 = b2 + kstep;
            if (last && has_next) S.a_ready(nxt);
            const int pgate = (Epi::HAS_MID && t >= ksplit) ? ((t - ksplit) >> 2) : -1;
            if constexpr (SP2) {
            PG8_LDB(B0, 0, 0); PG8_LDB(B1, 0, 1); PG8_SCHED; PG8_LDA(At, 0, 0); PG8_STAGE(PG8_SA(1, 1), a1 + hstepA, voffA);
            PG8_WAIT_V(8); PG8_WAIT_L(0); PG8_BAR; PG8_MMAM(0, 0, At, B0); PG8_MMAM(0, 1, At, B1); PG8_BAR; PG8_SCHED;
            PG8_LDA(At, 0, 1); PG8_STAGE(PG8_SB(0, 0), b2, voffB); PG8_STAGE(PG8_SB(0, 1), b2 + hstepB, voffB); PG8_STAGE(PG8_SA(0, 0), a2, voffA);
            PG8_WAIT_V(8); PG8_WAIT_L(0); PG8_BAR; PG8_MMAM(1, 0, At, B0); PG8_MMAM(1, 1, At, B1); PG8_BAR; PG8_SCHED;
            PG8_LDB(B0, 1, 0); PG8_LDB(B1, 1, 1); PG8_SCHED; PG8_LDA(At, 1, 0); PG8_STAGE(PG8_SA(0, 1), a2 + hstepA, voffA);
            PG8_WAIT_V(8); PG8_WAIT_L(0); PG8_BAR; PG8_MMAM(0, 0, At, B0); PG8_MMAM(0, 1, At, B1); PG8_BAR; PG8_SCHED;
            PG8_LDA(At, 1, 1); PG8_STAGE(PG8_SB(1, 0), b3, voffB); PG8_STAGE(PG8_SB(1, 1), b3 + hstepB, voffB); PG8_STAGE(PG8_SA(1, 0), a3, voffA);
            PG8_WAIT_V(8); PG8_WAIT_L(0); PG8_BAR; PG8_MMAM(1, 0, At, B0); PG8_MMAM(1, 1, At, B1); PG8_BAR; PG8_SCHED;
            } else {
            PG8_LDB(B0, 0, 0); PG8_SCHED; PG8_LDA(At, 0, 0); PG8_STAGE(PG8_SA(1, 1), a1 + hstepA, voffA);
            PG8_WAIT_L(8); PG8_BAR; PG8_WAIT_L(0); PG8_MMA(0, 0, At, B0); PG8_BAR; PG8_SCHED;
            PG8_LDB(B1, 0, 1); PG8_STAGE(PG8_SB(0, 0), b2, voffB);
            PG8_BAR; PG8_WAIT_L(0); PG8_MMA(0, 1, At, B1); PG8_BAR;
            PG8_LDA(At, 0, 1); PG8_STAGE(PG8_SA(0, 0), a2, voffA);
            PG8_BAR; PG8_WAIT_L(0); PG8_MMA(1, 0, At, B0); PG8_BAR; PG8_SCHED;
            PG8_STAGE(PG8_SB(0, 1), b2 + hstepB, voffB);
            PG8_WAIT_V(6); PG8_BAR; PG8_MMA(1, 1, At, B1); PG8_BAR;
            PG8_LDB(B0, 1, 0); PG8_SCHED; PG8_LDA(At, 1, 0); PG8_STAGE(PG8_SA(0, 1), a2 + hstepA, voffA);
            PG8_WAIT_L(8); PG8_BAR; PG8_WAIT_L(0); PG8_MMA(0, 0, At, B0); PG8_BAR; PG8_SCHED;
            PG8_LDB(B1, 1, 1); PG8_STAGE(PG8_SB(1, 0), b3, voffB);
            PG8_BAR; PG8_WAIT_L(0); PG8_MMA(0, 1, At, B1); PG8_BAR;
            PG8_LDA(At, 1, 1); PG8_STAGE(PG8_SA(1, 0), a3, voffA);
            PG8_BAR; PG8_WAIT_L(0); PG8_MMA(1, 0, At, B0); PG8_BAR; PG8_SCHED;
            PG8_STAGE(PG8_SB(1, 1), b3 + hstepB, voffB);
            PG8_WAIT_V(6); PG8_BAR; PG8_MMA(1, 1, At, B1); PG8_BAR;
            }
        }
        if constexpr (ALIGN_EPI) { if (wr == 0) PG8_BAR; }
        E(acc, cur, wr, wc, fr, fq); S.done(cur);
        if (!has_next) break;
#pragma unroll
        for (int a = 0; a < 2; ++a)
#pragma unroll
            for (int b = 0; b < 2; ++b)
#pragma unroll
                for (int m = 0; m < 4; ++m)
#pragma unroll
                    for (int n = 0; n < 2; ++n) acc[a][b][m][n] = (f32x4){0.f, 0.f, 0.f, 0.f};
        cur = nxt; cA = nA; cB = nB; ++ui;
        if constexpr (ALIGN_EPI) { if (wr == 1) PG8_BAR; }
    }
    PG8_WAIT_V(0);
    if constexpr (!ALIGN_EPI) { if (wr == 0) PG8_BAR; }
    PG8_BAR;
#undef PG8_AT
#undef PG8_SA
#undef PG8_SB
#undef PG8_STAGE
#undef PG8_LDA
#undef PG8_LDB
#undef PG8_MMA
#undef PG8_MMAM
#undef PG8_WAIT_V
#undef PG8_WAIT_L
#undef PG8_BAR
#undef PG8_SCHED
}
}

constexpr int NB = 8, SEQ = 4096, D = 1024, T = NB * SEQ, MEML = 256, MT = NB * MEML, FF = 4096, DEPTH = 2;
constexpr int INW = 6840, ZW = 2816;
constexpr float EPS = 1e-6f;
constexpr int Z_CQ = 0, Z_CKV = 256, Z_KPE = 384, Z_GLR = 416, Z_DA = 432, Z_DB = 436, Z_SGU = 512, Z_SGV = 768, Z_GQ = 1024, Z_GK = 1152, Z_GV = 1280, Z_GOG = 1536, Z_DQ = 1792, Z_DZ = 2560;

constexpr size_t MiB = 1u << 20;
constexpr size_t WS_CTL = 0, CTL_ZERO_BYTES = 64 * 1024;
constexpr size_t WS_ROPEC = 1 * MiB, WS_ROPES = 3 * MiB;
constexpr size_t WS_KX = 5 * MiB, WS_VX = 9 * MiB, WS_MEMN = 13 * MiB;
constexpr size_t WS_WZ = 17 * MiB;
constexpr size_t WS_WMLA = WS_WZ + 5 * MiB + MiB / 2;
constexpr size_t WS_WMRG = WS_WMLA + 1 * MiB;
constexpr size_t WS_WOUT = WS_WMRG + 16 * MiB;
constexpr size_t WS_WXQ = WS_WOUT + 2 * MiB, WS_WXK = WS_WXQ + 2 * MiB, WS_WXV = WS_WXK + 2 * MiB, WS_WXO = WS_WXV + 2 * MiB;
constexpr size_t WS_WUP = WS_WXO + 2 * MiB;
constexpr size_t WS_WDN = WS_WUP + 8 * MiB;
static_assert(WS_WDN + 8 * MiB <= 66 * MiB, "weights");
constexpr size_t WS_HB = 66 * MiB;
constexpr size_t WS_BR = 130 * MiB;
constexpr size_t WS_ZA = 194 * MiB;
constexpr size_t WS_ZB = 258 * MiB;
constexpr size_t WS_Q = 370 * MiB, WS_K = WS_Q + 24 * MiB, WS_V = WS_K + 24 * MiB;
constexpr size_t WS_XC = 194 * MiB, WS_WT = 210 * MiB, WS_KDT = 226 * MiB, WS_QD = 242 * MiB;
constexpr size_t WS_AT = 434 * MiB, WS_BS = 450 * MiB, WS_EG = 466 * MiB, WS_GL = 466 * MiB + 512 * 1024, WS_SNT = 467 * MiB;
constexpr size_t WS_PJ = 194 * MiB;
constexpr size_t WS_MG = 130 * MiB, WS_XQ = 258 * MiB, WS_XO = 322 * MiB;
constexpr size_t WS_HID = 130 * MiB;
constexpr size_t WS_ZF = 498 * MiB;
constexpr size_t WS_SSQ = 502 * MiB;
constexpr size_t WS_WSM = 503 * MiB;
constexpr size_t WS_SS16 = 504 * MiB;
constexpr size_t WS_SS16B = 506 * MiB;
constexpr size_t WS_R1 = 508 * MiB;
constexpr size_t WS_END = 509 * MiB;

constexpr int CW_TMO = 0, CW_CODE = 1, CW_BAR = 4096, CW_Q = 8192;

constexpr int RING_OFF = 0, G1_OFF = 139264, RING_BYTES = 139264 + 4 * 4096;
constexpr int LDSCTL_OFF = RING_BYTES, MISC_OFF = LDSCTL_OFF + 320;
constexpr int LDS_BYTES = 163840;

#define GAS __attribute__((address_space(1)))
#define LAS __attribute__((address_space(3)))
typedef unsigned short bf16;
typedef unsigned v4u __attribute__((ext_vector_type(4)));
typedef unsigned v2u __attribute__((ext_vector_type(2)));
typedef float f32x4 __attribute__((ext_vector_type(4)));
typedef GAS unsigned gu32;
#define RLX_AGENT __ATOMIC_RELAXED, __HIP_MEMORY_SCOPE_AGENT
#define LDS_WAIT() asm volatile("s_waitcnt lgkmcnt(0)" ::: "memory")
#define VM_WAIT() asm volatile("s_waitcnt vmcnt(0)" ::: "memory")
__device__ __forceinline__ unsigned f2bf(float f) { unsigned u = __builtin_bit_cast(unsigned, f); return (u + 0x7fffu + ((u >> 16) & 1u)) >> 16; }
__device__ __forceinline__ unsigned pk2(float lo, float hi) { return f2bf(lo) | (f2bf(hi) << 16); }
__device__ __forceinline__ float bf2f(unsigned short b) { return __uint_as_float(((unsigned)b) << 16); }
__device__ __forceinline__ float bflo(unsigned w) { return __uint_as_float(w << 16); }
__device__ __forceinline__ float bfhi(unsigned w) { return __uint_as_float(w & 0xffff0000u); }

#define XB_TMO      128
#define XB_XCNT(j)  (256  + 64 * (j))
#define XB_XSUB(j)  (1280 + 64 * (j))
#define XB_XGEN(j)  (2304 + 64 * (j))
#define XB_TOP      3328
#define XB_TOPGEN   3392
#define XCD_BAR_WORDS 3456
#define XB_SPIN_CAP (1u << 18)
__device__ __forceinline__ unsigned xb_ld(unsigned* p)              { return __hip_atomic_load(p, __ATOMIC_RELAXED, __HIP_MEMORY_SCOPE_AGENT); }
__device__ __forceinline__ unsigned xb_add(unsigned* p, unsigned v) { return __hip_atomic_fetch_add(p, v, __ATOMIC_RELAXED, __HIP_MEMORY_SCOPE_AGENT); }
__device__ __forceinline__ unsigned xb_xcc_id() { return (unsigned)__builtin_amdgcn_s_getreg((3 << 11) | 20) & 0xFu; }
#define XB_SPIN(cond, bar) do { unsigned _sp = 0; while (cond) { __builtin_amdgcn_s_sleep(1); \
    if ((++_sp & 255u) == 0u) { if (xb_ld(&(bar)[XB_TMO])) break; if (_sp > XB_SPIN_CAP) { atomicAdd(&(bar)[XB_TMO], 1u); break; } } } } while (0)
struct XcdBarrier { unsigned* bar; unsigned x; volatile LAS unsigned* st; };
__device__ __forceinline__ XcdBarrier xcd_barrier_post(unsigned* bar, volatile LAS unsigned* st) {
    XcdBarrier b; b.bar = bar; b.x = xb_xcc_id(); b.st = st;
    if (threadIdx.x == 0) (void)xb_add(&bar[XB_XCNT(b.x)], 1u);
    return b;
}
__device__ __forceinline__ void xcd_barrier_complete(unsigned* bar, unsigned x, unsigned& nloc, unsigned& nx) {
    const unsigned G = gridDim.x * gridDim.y * gridDim.z;
    unsigned sum, cnt, mine, sp = 0u;
    for (;;) {
        sum = 0u; cnt = 0u; mine = 0u;
        { unsigned cv[16];
#pragma unroll
          for (unsigned j = 0; j < 16; ++j) asm volatile("global_load_dword %0, %1, off sc1" : "=v"(cv[j]) : "v"(&bar[XB_XCNT(j)]) : "memory");
          asm volatile("s_waitcnt vmcnt(0)" : "+v"(cv[0]), "+v"(cv[1]), "+v"(cv[2]), "+v"(cv[3]), "+v"(cv[4]), "+v"(cv[5]), "+v"(cv[6]), "+v"(cv[7]), "+v"(cv[8]), "+v"(cv[9]), "+v"(cv[10]), "+v"(cv[11]), "+v"(cv[12]), "+v"(cv[13]), "+v"(cv[14]), "+v"(cv[15]) :: "memory");
#pragma unroll
          for (unsigned j = 0; j < 16; ++j) { const unsigned c = cv[j]; sum += c; cnt += (c > 0u) ? 1u : 0u; mine = (j == x) ? c : mine; } }
        if (sum == G) break;
        __builtin_amdgcn_s_sleep(1);
        if ((++sp & 255u) == 0u) { if (xb_ld(&bar[XB_TMO])) break; if (sp > XB_SPIN_CAP) { atomicAdd(&bar[XB_TMO], 1u); break; } }
    }
    nloc = mine > 0u ? mine : 1u; nx = cnt > 0u ? cnt : 1u;
}
__device__ __forceinline__ void xcd_barrier(const XcdBarrier& b) {
    asm volatile("s_waitcnt vmcnt(0)" ::: "memory");
    __syncthreads();
    if (threadIdx.x == 0) {
        unsigned* bar = b.bar;
        __builtin_amdgcn_s_waitcnt(0);
        unsigned nloc = b.st[0], nx = b.st[1];
        if (nloc == 0u) { xcd_barrier_complete(bar, b.x, nloc, nx); b.st[0] = nloc; b.st[1] = nx; }
        const unsigned old = xb_add(&bar[XB_XSUB(b.x)], 1u);
        const unsigned gen = old / nloc;
        if (old + 1u == (gen + 1u) * nloc) {
            __builtin_amdgcn_fence(__ATOMIC_RELEASE, "agent");
            asm volatile("s_waitcnt vmcnt(0)" ::: "memory");
            const unsigned og = xb_add(&bar[XB_TOP], 1u);
            const unsigned tg = og / nx;
            if (og + 1u == (tg + 1u) * nx) xb_add(&bar[XB_TOPGEN], 1u);
            else XB_SPIN(xb_ld(&bar[XB_TOPGEN]) == tg, bar);
            __builtin_amdgcn_fence(__ATOMIC_ACQUIRE, "agent");
            xb_add(&bar[XB_XGEN(b.x)], 1u);
            asm volatile("s_waitcnt vmcnt(0)" ::: "memory");
        } else {
            XB_SPIN(xb_ld(&bar[XB_XGEN(b.x)]) == gen, bar);
            asm volatile("buffer_inv sc0\n\ts_waitcnt vmcnt(0)" ::: "memory");
        }
    }
    __syncthreads();
}

constexpr int NWAVES = 8;
struct Frame {
    LAS unsigned char* lds;
    int tid, lane, wave;
    int vcu, G;
};
__device__ __forceinline__ float dpp_row_sum(float v) {
    v += __int_as_float(__builtin_amdgcn_update_dpp(0, __float_as_int(v), 0xB1, 0xF, 0xF, true));
    v += __int_as_float(__builtin_amdgcn_update_dpp(0, __float_as_int(v), 0x4E, 0xF, 0xF, true));
    v += __int_as_float(__builtin_amdgcn_update_dpp(0, __float_as_int(v), 0x141, 0xF, 0xF, true));
    v += __int_as_float(__builtin_amdgcn_update_dpp(0, __float_as_int(v), 0x140, 0xF, 0xF, true));
    return v;
}
__device__ __forceinline__ float wave_sum(float v) { v = dpp_row_sum(v); v += __shfl_xor(v, 16); v += __shfl_xor(v, 32); return v; }
__device__ __forceinline__ float sigmoidf_(float x) { return __builtin_amdgcn_rcpf(1.0f + __expf(-x)); }
__device__ __forceinline__ float gelu_tanh(float x) { const float y = 0.7978845608028654f * (x + 0.044715f * x * x * x); const float t = 1.0f - 2.0f / (1.0f + __expf(2.0f * y)); return 0.5f * x * (1.0f + t); }
__device__ __forceinline__ float log1pexp_neg(float e) { const float a = e * (1.0f - e * (0.5f - e * 0.33333333f)), b = __logf(1.0f + e); const unsigned m = (e < 1e-2f) ? 0xffffffffu : 0u;
    return __uint_as_float((__float_as_uint(a) & m) | (__float_as_uint(b) & ~m)); }
__device__ __forceinline__ float softplusf_(float x) { return fmaxf(x, 0.f) + log1pexp_neg(__expf(-fabsf(x))); }
__device__ __forceinline__ float logsigmoidf_(float x) { return fminf(x, 0.f) - log1pexp_neg(__expf(-fabsf(x))); }

template <class Fn> __device__ __forceinline__ void wprep_tile(const Fn& f, bf16* dst, int ldd, int R0, int k0, LAS float* scr, int lane) {
#pragma unroll 1
    for (int i0 = 0; i0 < 32; i0 += 16) { float tv[16];
#pragma unroll
        for (int i = 0; i < 16; ++i) tv[i] = f(R0 + (lane & 31), k0 + 2 * (i0 + i) + (lane >> 5));
#pragma unroll
        for (int i = 0; i < 16; ++i) scr[(2 * (i0 + i) + (lane >> 5)) * 33 + (lane & 31)] = tv[i]; }
    LDS_WAIT(); asm volatile("" ::: "memory");
    const int c = lane & 7;
#pragma unroll
    for (int j = 0; j < 4; ++j) { const int n = (lane >> 3) + 8 * j; const LAS float* s = scr + (8 * c) * 33 + n;
        v4u o; o.x = pk2(s[0 * 33], s[1 * 33]); o.y = pk2(s[2 * 33], s[3 * 33]); o.z = pk2(s[4 * 33], s[5 * 33]); o.w = pk2(s[6 * 33], s[7 * 33]);
        *(GAS v4u*)(dst + (size_t)(R0 + n) * ldd + k0 + 8 * c) = o; }
    LDS_WAIT(); asm volatile("" ::: "memory");
}
__device__ __forceinline__ int zcol_src(int R) {
    if (R < 416) return R;
    if (R < 432) return 1440 + (R - 416);
    if (R < 436) return 2480 + (R - 432);
    if (R < 440) return 2484 + (R - 436);
    if (R < 512) return -1;
    if (R < 1024) return 416 + (R - 512);
    if (R < 1280) return 928 + (R - 1024);
    if (R < 1536) return 1184 + (R - 1280);
    if (R < 1792) return 1456 + (R - 1536);
    if (R < 2560) return 1712 + (R - 1792);
    return 2488 + (R - 2560);
}
struct FnWz { const float* win; const float* gain; __device__ __forceinline__ float operator()(int R, int k) const { const int c = zcol_src(R); const float w = gain[k] * win[(size_t)k * INW + (c < 0 ? 0 : c)]; return c < 0 ? 0.f : w; } };
struct FnZero { __device__ __forceinline__ float operator()(int, int) const { return 0.f; } };
struct FnWuq { const float* wuq; const float* nq;
    __device__ __forceinline__ float operator()(int R, int k) const { const int h = R / 96, o = R - 96 * h, jj = o - 64; const int sc = h * 96 + (o < 64 ? o : 64 + (jj & 1) * 16 + (jj >> 1)); return nq[k] * wuq[k * 384 + sc]; } };
struct FnWukv { const float* wukv; const float* nkv;
    __device__ __forceinline__ float operator()(int R, int k) const { return nkv[k - 256] * wukv[(k - 256) * 512 + (R - 384)]; } };
struct FnIdent { __device__ __forceinline__ float operator()(int R, int k) const { const int jj = R - 896; return (k == 384 + (jj & 1) * 16 + (jj >> 1)) ? 1.0f : 0.f; } };
struct FnWmrg { const float* win; const float* gain;
    __device__ __forceinline__ float operator()(int R, int k) const {
        const int pn = R >> 8, c = R & 255, bj = c >> 7, wc = (c >> 5) & 3, n = (c >> 4) & 1, fq = (c >> 2) & 3, e = c & 3;
        const int gate = 2 * bj + n, d = 64 * pn + 16 * wc + 4 * fq + e;
        return gain[k] * win[(size_t)k * INW + 2744 + gate * 1024 + d]; } };
template <bool GAIN> struct FnT { const float* W; int N; const float* gain; __device__ __forceinline__ float operator()(int R, int k) const { const float w = W[(size_t)k * N + R]; if constexpr (GAIN) return gain[k] * w; else return w; } };

__device__ __forceinline__ void rms_row_bf16(const float* xrow, const float* gain, bf16* orow, int lane) {
    const GAS f32x4* xr = (const GAS f32x4*)xrow + lane; const GAS f32x4* gr = (const GAS f32x4*)gain + lane;
    f32x4 v[4]; float s = 0.f;
#pragma unroll
    for (int j = 0; j < 4; ++j) { v[j] = xr[64 * j]; s += (v[j].x * v[j].x + v[j].y * v[j].y) + (v[j].z * v[j].z + v[j].w * v[j].w); }
    const float r = 1.0f / sqrtf(wave_sum(s) * (1.f / 1024.f) + EPS);
    GAS unsigned long long* o8 = (GAS unsigned long long*)orow + lane;
#pragma unroll
    for (int j = 0; j < 4; ++j) { const f32x4 gg = gr[64 * j]; o8[64 * j] = (unsigned long long)pk2(v[j].x * r * gg.x, v[j].y * r * gg.y) | ((unsigned long long)pk2(v[j].z * r * gg.z, v[j].w * r * gg.w) << 32); }
}
__device__ __forceinline__ void rope_entry(int pos, int j, float& c, float& s) {
    const int q4 = j >> 2, r4 = j & 3;
    float ff = (r4 == 0) ? 1.0f : (r4 == 1) ? 0.5623413251903491f : (r4 == 2) ? 0.31622776601683794f : 0.17782794100389228f;
    ff *= (q4 == 0) ? 1.0f : (q4 == 1) ? 0.1f : (q4 == 2) ? 0.01f : 0.001f;
    const double ang = (double)pos * (double)ff;
    const double kq = __builtin_rint(ang * 0.6366197723675814);
    const float r = (float)(ang - kq * 1.5707963267948966), r2 = r * r;
    const float sn = r + r * r2 * (-1.0f / 6 + r2 * (1.0f / 120 + r2 * (-1.0f / 5040 + r2 * (1.0f / 362880))));
    const float cs = 1.0f + r2 * (-0.5f + r2 * (1.0f / 24 + r2 * (-1.0f / 720 + r2 * (1.0f / 40320 + r2 * (-1.0f / 3628800)))));
    const int q = ((int)kq) & 3;
    s = (q == 0) ? sn : (q == 1) ? cs : (q == 2) ? -sn : -cs;
    c = (q == 0) ? cs : (q == 1) ? -sn : (q == 2) ? -cs : sn;
}


typedef float f32x16 __attribute__((ext_vector_type(16)));
typedef short bf16x8v __attribute__((ext_vector_type(8)));
__device__ __forceinline__ float rdlane(float v, int l) { return __int_as_float(__builtin_amdgcn_readlane(__float_as_int(v), l)); }
__device__ __forceinline__ unsigned pkbf(float lo, float hi) { return pg8::cvt_pk_bf16(lo, hi); }
using pg8::row_rscale;
constexpr int ZBW = 1792;
constexpr int ZB_GQ = 0, ZB_GK = 128, ZB_GV = 256, ZB_GOG = 512, ZB_DQ = 768, ZB_DK = 1024, ZB_DV = 1280, ZB_DZ = 1536;
constexpr int XKS = 68;

__device__ __forceinline__ void gla1_item(int item, int lane, bf16* ZBp, const float* ZFp, const float* wg, const float* bg, float* BS, float* EG) {
    asm volatile("" : "+v"(lane));
    const int chunk = item >> 2, h = item & 3, kap = lane & 31, half = lane >> 5; const size_t t0 = (size_t)chunk * 64;
    char* zrow = (char*)(ZBp + t0 * ZBW + h * 32); const unsigned loff = (unsigned)((32 * half * ZBW + kap) * 2);
    const char* frow = (const char*)(ZFp + t0 * 32); const unsigned foff = (unsigned)(32 * half * 32 * 4);
    float w[16];
#pragma unroll
    for (int r = 0; r < 16; ++r) w[r] = wg[r * 128 + h * 32 + kap];
    const float bb = bg[h * 32 + kap];
    float ls[32]; float tot = 0.f;
#pragma unroll
    for (int jj = 0; jj < 32; ++jj) { const char* zf = frow + (size_t)(jj * 32 * 4) + foff; float pre = bb;
        const f32x4 z0 = *(const f32x4*)zf, z1 = *(const f32x4*)(zf + 16), z2 = *(const f32x4*)(zf + 32), z3 = *(const f32x4*)(zf + 48);
        pre += z0[0] * w[0] + z0[1] * w[1] + z0[2] * w[2] + z0[3] * w[3] + z1[0] * w[4] + z1[1] * w[5] + z1[2] * w[6] + z1[3] * w[7]
             + z2[0] * w[8] + z2[1] * w[9] + z2[2] * w[10] + z2[3] * w[11] + z3[0] * w[12] + z3[1] * w[13] + z3[2] * w[14] + z3[3] * w[15];
        ls[jj] = logsigmoidf_(pre) * (1.0f / 16.0f); tot += ls[jj]; }
    asm volatile("" ::: "memory");
    unsigned short kr[32], qr[32];
#pragma unroll
    for (int jj = 0; jj < 32; ++jj) { kr[jj] = *(const bf16*)(zrow + (size_t)(jj * ZBW + ZB_GK) * 2 + loff); qr[jj] = *(const bf16*)(zrow + (size_t)(jj * ZBW + ZB_GQ) * 2 + loff); }
    unsigned short vr[2][32];
#pragma unroll
    for (int jj = 0; jj < 32; ++jj) { const char* vp = zrow + (size_t)(jj * ZBW + ZB_GV + h * 32) * 2 + loff; vr[0][jj] = *(const bf16*)vp; vr[1][jj] = *(const bf16*)(vp + 64); }
    const float other = __shfl_xor(tot, 32); float cum = half ? other : 0.f;
    unsigned ka[16];
#pragma unroll
    for (int jj = 0; jj < 32; ++jj) { cum += ls[jj];
        const unsigned k16v = f2bf(bf2f(kr[jj]) * __expf(-cum)), q16v = f2bf(bf2f(qr[jj]) * 0.17677669529663687f * __expf(cum));
        *(bf16*)(zrow + (size_t)(jj * ZBW + ZB_GK) * 2 + loff) = (bf16)k16v; *(bf16*)(zrow + (size_t)(jj * ZBW + ZB_GQ) * 2 + loff) = (bf16)q16v;
        if (jj & 1) ka[jj >> 1] |= k16v << 16; else ka[jj >> 1] = k16v; }
    tot += other;
    char* bsrow = (char*)(BS + (size_t)item * 2048); const unsigned boff = (unsigned)((4 * half * 64 + kap) * 4);
#pragma unroll
    for (int nb = 0; nb < 2; ++nb) { f32x16 acc;
#pragma unroll
        for (int r = 0; r < 16; ++r) acc[r] = 0.f;
#pragma unroll
        for (int st = 0; st < 4; ++st) { v4u av, bv; av.x = ka[4 * st]; av.y = ka[4 * st + 1]; av.z = ka[4 * st + 2]; av.w = ka[4 * st + 3];
            bv.x = (unsigned)vr[nb][8 * st] | ((unsigned)vr[nb][8 * st + 1] << 16); bv.y = (unsigned)vr[nb][8 * st + 2] | ((unsigned)vr[nb][8 * st + 3] << 16);
            bv.z = (unsigned)vr[nb][8 * st + 4] | ((unsigned)vr[nb][8 * st + 5] << 16); bv.w = (unsigned)vr[nb][8 * st + 6] | ((unsigned)vr[nb][8 * st + 7] << 16);
            acc = __builtin_amdgcn_mfma_f32_32x32x16_bf16(__builtin_bit_cast(bf16x8v, av), __builtin_bit_cast(bf16x8v, bv), acc, 0, 0, 0); }
#pragma unroll
        for (int r = 0; r < 16; ++r) *(float*)(bsrow + (size_t)((((r & 3) + 8 * (r >> 2)) * 64 + 32 * nb) * 4) + boff) = acc[r]; }
    if (half == 0) EG[item * 32 + kap] = __expf(tot);
}
template <bool XS> __device__ __forceinline__ void dn1_solve(LAS float* Tl, const LAS float* Lm, int c, float beta, float gam, bf16* XCp) {
#pragma unroll 1
    for (int b = 0; b < 4; ++b) { float acc[16];
        { float t16[16];
#pragma unroll
          for (int r = 0; r < 16; ++r) t16[r] = Tl[(16 * b + r) * XKS + c];
          __builtin_amdgcn_sched_barrier(0);
#pragma unroll
          for (int r = 0; r < 16; ++r) { const int i = 16 * b + r; float sc = rdlane(beta, i); if (XS) sc *= __expf(rdlane(gam, i)); acc[r] = sc * t16[r]; } }
        for (int jb = 0; jb < b; ++jb) {
#pragma unroll 1
            for (int jq = 0; jq < 4; ++jq) { const LAS float* xp = Tl + (16 * jb + 4 * jq) * XKS + c; const float x0 = xp[0], x1 = xp[XKS], x2 = xp[2 * XKS], x3 = xp[3 * XKS];
                f32x4 l[16];
#pragma unroll
                for (int r = 0; r < 16; ++r) l[r] = *(const LAS f32x4*)(Lm + (16 * b + r) * XKS + 16 * jb + 4 * jq);
                __builtin_amdgcn_sched_barrier(0);
#pragma unroll
                for (int r = 0; r < 16; ++r) acc[r] -= (l[r][0] * x0 + l[r][1] * x1) + (l[r][2] * x2 + l[r][3] * x3); } }
        float xs[16];
        xs[0] = acc[0];
#pragma unroll
        for (int g4 = 0; g4 < 4; ++g4) {
            f32x4 ld[4][4];
#pragma unroll
            for (int rr = 0; rr < 4; ++rr)
#pragma unroll
                for (int q = 0; q < 4; ++q) if (4 * q < 4 * g4 + rr) ld[rr][q] = *(const LAS f32x4*)(Lm + (16 * b + 4 * g4 + rr) * XKS + 16 * b + 4 * q);
            __builtin_amdgcn_sched_barrier(0);
#pragma unroll
            for (int rr = 0; rr < 4; ++rr) { const int r = 4 * g4 + rr; if (r == 0) continue; float v = acc[r];
#pragma unroll
                for (int q = 0; q < 4; ++q) if (4 * q < r) {
#pragma unroll
                    for (int e = 0; e < 4; ++e) if (4 * q + e < r) v -= ld[rr][q][e] * xs[4 * q + e]; }
                xs[r] = v; } }
#pragma unroll
        for (int r = 0; r < 16; ++r) { Tl[(16 * b + r) * XKS + c] = xs[r]; if (XS) XCp[(16 * b + r) * 64] = (bf16)f2bf(xs[r]); } }
}
__device__ __forceinline__ void dn1_item(int item, int lane, LAS float* Xk, LAS float* Lm, const bf16* ZBp, const float* ZFp, const float* cw, float Aexp, float dtb,
                                         bf16* XC, bf16* WT, bf16* KDT, bf16* QD, bf16* AT, float* GL) {
    asm volatile("" : "+v"(lane));
    const int chunk = item >> 2, h = item & 3; const size_t t0 = (size_t)chunk * 64; const int s0 = (int)(t0 & (SEQ - 1));
    const size_t t = t0 + lane; const size_t ib = (size_t)item * 4096; const int c = lane;
    { const float* wq = cw + h * 64 + lane; const float* wk = cw + 256 + h * 64 + lane;
      const float q0w = wq[0], q1w = wq[768], q2w = wq[2 * 768], q3w = wq[3 * 768], k0w = wk[0], k1w = wk[768], k2w = wk[2 * 768], k3w = wk[3 * 768];
      const bf16* qcol = ZBp + t0 * ZBW + ZB_DQ + h * 64 + lane; const bf16* kcol = qcol + 256;
      float xq0 = 0.f, xq1 = 0.f, xq2 = 0.f, xk0 = 0.f, xk1 = 0.f, xk2 = 0.f;
      if (s0 > 0) { xq0 = bf2f(*(qcol - 3 * ZBW)); xq1 = bf2f(*(qcol - 2 * ZBW)); xq2 = bf2f(*(qcol - ZBW)); xk0 = bf2f(*(kcol - 3 * ZBW)); xk1 = bf2f(*(kcol - 2 * ZBW)); xk2 = bf2f(*(kcol - ZBW)); }
#pragma unroll 1
      for (int ih = 0; ih < 64; ih += 32) { unsigned short rq[32], rk[32];
#pragma unroll
          for (int i = 0; i < 32; ++i) { rq[i] = qcol[(size_t)(ih + i) * ZBW]; rk[i] = kcol[(size_t)(ih + i) * ZBW]; }
#pragma unroll
          for (int i = 0; i < 32; ++i) { const float x3 = bf2f(rq[i]); const float a = q0w * xq0 + q1w * xq1 + q2w * xq2 + q3w * x3; Lm[(ih + i) * XKS + lane] = a * sigmoidf_(a); xq0 = xq1; xq1 = xq2; xq2 = x3;
              const float y3 = bf2f(rk[i]); const float bq = k0w * xk0 + k1w * xk1 + k2w * xk2 + k3w * y3; Xk[(ih + i) * XKS + lane] = bq * sigmoidf_(bq); xk0 = xk1; xk1 = xk2; xk2 = y3; } } }
    LDS_WAIT(); asm volatile("" ::: "memory");
    { float ssq = 0.f;
#pragma unroll 4
      for (int d4 = 0; d4 < 16; ++d4) { const f32x4 r4 = *(const LAS f32x4*)(Xk + lane * XKS + 4 * d4); ssq += (r4[0] * r4[0] + r4[1] * r4[1]) + (r4[2] * r4[2] + r4[3] * r4[3]); }
      const float rn = 1.0f / sqrtf(ssq + EPS);
#pragma unroll 4
      for (int d4 = 0; d4 < 16; ++d4) { const f32x4 r4 = *(const LAS f32x4*)(Xk + lane * XKS + 4 * d4); *(LAS f32x4*)(Xk + lane * XKS + 4 * d4) = r4 * rn; } }
    asm volatile("" ::: "memory");
    { float ssq = 0.f;
#pragma unroll 4
      for (int d4 = 0; d4 < 16; ++d4) { const f32x4 r4 = *(const LAS f32x4*)(Lm + lane * XKS + 4 * d4); ssq += (r4[0] * r4[0] + r4[1] * r4[1]) + (r4[2] * r4[2] + r4[3] * r4[3]); }
      const float rn = 0.125f / sqrtf(ssq + EPS);
#pragma unroll 4
      for (int d4 = 0; d4 < 16; ++d4) { const f32x4 r4 = *(const LAS f32x4*)(Lm + lane * XKS + 4 * d4); *(LAS f32x4*)(Lm + lane * XKS + 4 * d4) = r4 * rn; } }
    const float beta = sigmoidf_(ZFp[t * 32 + 20 + h]);
    float gam = -Aexp * softplusf_(ZFp[t * 32 + 16 + h] + dtb);
#pragma unroll
    for (int o = 1; o < 64; o <<= 1) { const float tmp = __shfl_up(gam, o); if (lane >= o) gam += tmp; }
    const float glast = rdlane(gam, 63);
    Xk[lane * XKS + 64] = gam; Xk[lane * XKS + 65] = beta;
    LDS_WAIT(); asm volatile("" ::: "memory");
    const int cc = lane & 31, hh = lane >> 5;
#pragma unroll 1
    for (int tIJ = 0; tIJ < 4; ++tIJ) { const int tI = tIJ >> 1, tJ = tIJ & 1; f32x16 acc;
#pragma unroll
            for (int r = 0; r < 16; ++r) acc[r] = 0.f;
            if (tI >= tJ) {
                f32x4 a4[8], b4[8];
#pragma unroll
                for (int u = 0; u < 8; ++u) { a4[u] = *(const LAS f32x4*)(Lm + (32 * tI + cc) * XKS + 32 * hh + 4 * u); b4[u] = *(const LAS f32x4*)(Xk + (32 * tJ + cc) * XKS + 32 * hh + 4 * u); }
                __builtin_amdgcn_sched_barrier(0);
#pragma unroll
                for (int u = 0; u < 8; ++u)
#pragma unroll
                    for (int e = 0; e < 4; ++e) acc = __builtin_amdgcn_mfma_f32_32x32x2f32(a4[u][e], b4[u][e], acc, 0, 0, 0); }
            const int j = 32 * tJ + cc; const float gj = Xk[j * XKS + 64]; bf16* atp = AT + ib + j;
            float gi[16];
#pragma unroll
            for (int r = 0; r < 16; ++r) gi[r] = Xk[(32 * tI + (r & 3) + 8 * (r >> 2) + 4 * hh) * XKS + 64];
            __builtin_amdgcn_sched_barrier(0);
#pragma unroll
            for (int r = 0; r < 16; ++r) { const int i = 32 * tI + (r & 3) + 8 * (r >> 2) + 4 * hh; const float val = acc[r] * __expf(fminf(gi[r] - gj, 0.f));
                atp[i * 64] = (bf16)f2bf((j <= i) ? val : 0.f); } }
    { const float eg = __expf(gam); int ln = lane; asm volatile("" : "+v"(ln)); bf16* qdp = QD + ib + ln * 64;
#pragma unroll 2
      for (int d8 = 0; d8 < 8; ++d8) { const f32x4 p0 = *(const LAS f32x4*)(Lm + ln * XKS + 8 * d8) * eg, p1 = *(const LAS f32x4*)(Lm + ln * XKS + 8 * d8 + 4) * eg;
          v4u w; w.x = pkbf(p0[0], p0[1]); w.y = pkbf(p0[2], p0[3]); w.z = pkbf(p1[0], p1[1]); w.w = pkbf(p1[2], p1[3]); *(v4u*)(qdp + 8 * d8) = w; } }
    { const float ek = __expf(glast - gam); int ln = lane; asm volatile("" : "+v"(ln)); bf16* kdp = KDT + ib + ln;
#pragma unroll 2
      for (int d4 = 0; d4 < 16; ++d4) { const f32x4 r4 = *(const LAS f32x4*)(Xk + ln * XKS + 4 * d4) * ek;
          kdp[(4 * d4) * 64] = (bf16)f2bf(r4[0]); kdp[(4 * d4 + 1) * 64] = (bf16)f2bf(r4[1]); kdp[(4 * d4 + 2) * 64] = (bf16)f2bf(r4[2]); kdp[(4 * d4 + 3) * 64] = (bf16)f2bf(r4[3]); } }
    LDS_WAIT(); asm volatile("" ::: "memory");
#pragma unroll 1
    for (int tIJ = 0; tIJ < 4; ++tIJ) { const int tI = tIJ >> 1, tJ = tIJ & 1; f32x16 acc;
#pragma unroll
            for (int r = 0; r < 16; ++r) acc[r] = 0.f;
            if (tI >= tJ) {
                f32x4 a4[8], b4[8];
#pragma unroll
                for (int u = 0; u < 8; ++u) { a4[u] = *(const LAS f32x4*)(Xk + (32 * tI + cc) * XKS + 32 * hh + 4 * u); b4[u] = *(const LAS f32x4*)(Xk + (32 * tJ + cc) * XKS + 32 * hh + 4 * u); }
                __builtin_amdgcn_sched_barrier(0);
#pragma unroll
                for (int u = 0; u < 8; ++u)
#pragma unroll
                    for (int e = 0; e < 4; ++e) acc = __builtin_amdgcn_mfma_f32_32x32x2f32(a4[u][e], b4[u][e], acc, 0, 0, 0); }
            const int j = 32 * tJ + cc; const float gj = Xk[j * XKS + 64];
            float gi[16], bi[16];
#pragma unroll
            for (int r = 0; r < 16; ++r) { const LAS float* gp = Xk + (32 * tI + (r & 3) + 8 * (r >> 2) + 4 * hh) * XKS + 64; gi[r] = gp[0]; bi[r] = gp[1]; }
            __builtin_amdgcn_sched_barrier(0);
#pragma unroll
            for (int r = 0; r < 16; ++r) { const int i = 32 * tI + (r & 3) + 8 * (r >> 2) + 4 * hh; const float val = bi[r] * acc[r] * __expf(fminf(gi[r] - gj, 0.f));
                Lm[i * XKS + j] = (j < i) ? val : 0.f; } }
    LDS_WAIT(); asm volatile("" ::: "memory");
    { int ln = lane; asm volatile("" : "+v"(ln)); dn1_solve<true>(Xk, Lm, c, beta, gam, XC + ib + ln); }
    LDS_WAIT(); asm volatile("" ::: "memory");
    { int ln = lane; asm volatile("" : "+v"(ln)); const float* wvv = cw + 512 + h * 64 + ln; const float w0 = wvv[0], w1 = wvv[768], w2 = wvv[2 * 768], w3 = wvv[3 * 768];
      const bf16* vcol = ZBp + t0 * ZBW + ZB_DV + h * 64 + ln;
      float x0 = 0.f, x1 = 0.f, x2 = 0.f;
      if (s0 > 0) { x0 = bf2f(*(vcol - 3 * ZBW)); x1 = bf2f(*(vcol - 2 * ZBW)); x2 = bf2f(*(vcol - ZBW)); }
#pragma unroll 1
      for (int ih = 0; ih < 64; ih += 32) { unsigned short raw[32];
#pragma unroll
          for (int i = 0; i < 32; ++i) raw[i] = vcol[(size_t)(ih + i) * ZBW];
#pragma unroll
          for (int i = 0; i < 32; ++i) { const float x3 = bf2f(raw[i]); const float a = w0 * x0 + w1 * x1 + w2 * x2 + w3 * x3; Xk[(ih + i) * XKS + c] = a * sigmoidf_(a); x0 = x1; x1 = x2; x2 = x3; } } }
    LDS_WAIT(); asm volatile("" ::: "memory");
    dn1_solve<false>(Xk, Lm, c, beta, gam, nullptr);
    LDS_WAIT(); asm volatile("" ::: "memory");
#pragma unroll 2
    for (int i8 = 0; i8 < 8; ++i8) { const LAS float* xp = Xk + (8 * i8) * XKS + c; v4u w; w.x = pkbf(xp[0], xp[XKS]); w.y = pkbf(xp[2 * XKS], xp[3 * XKS]); w.z = pkbf(xp[4 * XKS], xp[5 * XKS]); w.w = pkbf(xp[6 * XKS], xp[7 * XKS]);
        { int ln = lane; asm volatile("" : "+v"(ln)); *(v4u*)(WT + ib + ln * 64 + 8 * i8) = w; } }
    if (lane == 0) GL[item] = __expf(glast);
    LDS_WAIT(); asm volatile("" ::: "memory");
}
__device__ __forceinline__ bf16x8v ld_frag2x(const bf16* p16, int hh) { const v4u w = *(const v4u*)p16; const unsigned tx = hh ? w.x : w.z, ty = hh ? w.y : w.w;
    const unsigned rx = (unsigned)__shfl_xor((int)tx, 32), ry = (unsigned)__shfl_xor((int)ty, 32); v4u o; if (hh) { o.x = rx; o.y = ry; o.z = w.z; o.w = w.w; } else { o.x = w.x; o.y = w.y; o.z = rx; o.w = ry; } return __builtin_bit_cast(bf16x8v, o); }
__device__ __forceinline__ bf16x8v pack8(const f32x16& x, int s, float sgn) { v4u w; w.x = pkbf(sgn * x[8 * s], sgn * x[8 * s + 1]); w.y = pkbf(sgn * x[8 * s + 2], sgn * x[8 * s + 3]); w.z = pkbf(sgn * x[8 * s + 4], sgn * x[8 * s + 5]); w.w = pkbf(sgn * x[8 * s + 6], sgn * x[8 * s + 7]); return __builtin_bit_cast(bf16x8v, w); }
__device__ __forceinline__ void dn2_worker(int bh, int Jb, int lane, const bf16* XC, bf16* WT, const bf16* KDT, bf16* SNT, const float* GL) {
    const int b = bh >> 2, h = bh & 3, c = lane & 31, hh = lane >> 5;
    f32x16 S0, S1;
#pragma unroll
    for (int r = 0; r < 16; ++r) { S0[r] = 0.f; S1[r] = 0.f; }
    bf16x8v xn[2][2][2]; v2u wn0[4], wn1[4];
#define DN2_LOADX(n_) do { const size_t ib_ = ((size_t)((b * 64 + (n_)) * 4 + h)) * 4096; \
        _Pragma("unroll") for (int I = 0; I < 2; ++I) _Pragma("unroll") for (int K2 = 0; K2 < 2; ++K2) _Pragma("unroll") for (int s2 = 0; s2 < 2; ++s2) xn[I][K2][s2] = ld_frag2x(XC + ib_ + (32 * I + c) * 64 + 32 * K2 + 16 * s2 + 8 * hh, hh); \
        const bf16* wr_ = WT + ib_ + (32 * Jb + c) * 64 + 4 * hh; _Pragma("unroll") for (int g = 0; g < 4; ++g) { wn0[g] = *(const v2u*)(wr_ + 8 * g); wn1[g] = *(const v2u*)(wr_ + 32 + 8 * g); } } while (0)
    DN2_LOADX(0);
    for (int n = 0; n < 64; ++n) {
        const size_t ib = ((size_t)((b * 64 + n) * 4 + h)) * 4096;
        const float gl = GL[(b * 64 + n) * 4 + h];
        bf16x8v xa[2][2][2], ka[2][2][2]; f32x16 u0, u1;
#pragma unroll
        for (int I = 0; I < 2; ++I)
#pragma unroll
            for (int K2 = 0; K2 < 2; ++K2)
#pragma unroll
                for (int s2 = 0; s2 < 2; ++s2) { xa[I][K2][s2] = xn[I][K2][s2]; ka[K2][I][s2] = ld_frag2x(KDT + ib + (32 * K2 + c) * 64 + 32 * I + 16 * s2 + 8 * hh, hh); }
#pragma unroll
        for (int g = 0; g < 4; ++g) { const v2u a = wn0[g], bq = wn1[g];
            u0[4 * g] = bflo(a.x); u0[4 * g + 1] = bfhi(a.x); u0[4 * g + 2] = bflo(a.y); u0[4 * g + 3] = bfhi(a.y);
            u1[4 * g] = bflo(bq.x); u1[4 * g + 1] = bfhi(bq.x); u1[4 * g + 2] = bflo(bq.y); u1[4 * g + 3] = bfhi(bq.y); }
        if (n + 1 < 64) DN2_LOADX(n + 1);
        bf16* wrow = WT + ib + (32 * Jb + c) * 64 + 4 * hh;
        bf16* srow = SNT + ib + (32 * Jb + c) * 64 + 4 * hh;
#pragma unroll
        for (int g = 0; g < 4; ++g) { v2u a, bq; a.x = pkbf(S0[4 * g], S0[4 * g + 1]); a.y = pkbf(S0[4 * g + 2], S0[4 * g + 3]); bq.x = pkbf(S1[4 * g], S1[4 * g + 1]); bq.y = pkbf(S1[4 * g + 2], S1[4 * g + 3]);
            *(v2u*)(srow + 8 * g) = a; *(v2u*)(srow + 32 + 8 * g) = bq; }
#pragma unroll
        for (int s2 = 0; s2 < 2; ++s2) { const bf16x8v b0 = pack8(S0, s2, -1.f), b1 = pack8(S1, s2, -1.f);
            u0 = __builtin_amdgcn_mfma_f32_32x32x16_bf16(xa[0][0][s2], b0, u0, 0, 0, 0); u0 = __builtin_amdgcn_mfma_f32_32x32x16_bf16(xa[0][1][s2], b1, u0, 0, 0, 0);
            u1 = __builtin_amdgcn_mfma_f32_32x32x16_bf16(xa[1][0][s2], b0, u1, 0, 0, 0); u1 = __builtin_amdgcn_mfma_f32_32x32x16_bf16(xa[1][1][s2], b1, u1, 0, 0, 0); }
#pragma unroll
        for (int g = 0; g < 4; ++g) { v2u a, bq; a.x = pkbf(u0[4 * g], u0[4 * g + 1]); a.y = pkbf(u0[4 * g + 2], u0[4 * g + 3]); bq.x = pkbf(u1[4 * g], u1[4 * g + 1]); bq.y = pkbf(u1[4 * g + 2], u1[4 * g + 3]);
            *(v2u*)(wrow + 8 * g) = a; *(v2u*)(wrow + 32 + 8 * g) = bq; }
        S0 = S0 * gl; S1 = S1 * gl;
#pragma unroll
        for (int s2 = 0; s2 < 2; ++s2) { const bf16x8v b0 = pack8(u0, s2, 1.f), b1 = pack8(u1, s2, 1.f);
            S0 = __builtin_amdgcn_mfma_f32_32x32x16_bf16(ka[0][0][s2], b0, S0, 0, 0, 0); S0 = __builtin_amdgcn_mfma_f32_32x32x16_bf16(ka[0][1][s2], b1, S0, 0, 0, 0);
            S1 = __builtin_amdgcn_mfma_f32_32x32x16_bf16(ka[1][0][s2], b0, S1, 0, 0, 0); S1 = __builtin_amdgcn_mfma_f32_32x32x16_bf16(ka[1][1][s2], b1, S1, 0, 0, 0); }
    }
#undef DN2_LOADX
}
constexpr int G3_VS = 72;
__device__ __forceinline__ void gla3m_item(int item, int lane, LAS unsigned char* Lw, const bf16* ZBp, const float* ZFp, const float* wg, const float* bg, const float* BS, const float* gnorm, bf16* BRp) {
    asm volatile("" : "+v"(lane));
    const int chunk = item >> 2, h = item & 3, c = lane & 31, hh = lane >> 5; const size_t t0 = (size_t)chunk * 64;
    LAS bf16* vT = (LAS bf16*)Lw;
    bf16x8v kf[2][2], qf[2][2];
#pragma unroll
    for (int I = 0; I < 2; ++I)
#pragma unroll
        for (int s2 = 0; s2 < 2; ++s2) { const bf16* rp = ZBp + (t0 + 32 * I + c) * ZBW + h * 32 + 16 * s2 + 8 * hh;
            kf[I][s2] = __builtin_bit_cast(bf16x8v, *(const v4u*)(rp + ZB_GK)); qf[I][s2] = __builtin_bit_cast(bf16x8v, *(const v4u*)(rp + ZB_GQ)); }
    { const bf16* vp = ZBp + t0 * ZBW + ZB_GV + h * 64 + lane;
#pragma unroll 1
      for (int jh = 0; jh < 64; jh += 32) { unsigned short raw[32];
#pragma unroll
          for (int j = 0; j < 32; ++j) raw[j] = vp[(size_t)(jh + j) * ZBW];
#pragma unroll
          for (int j = 0; j < 32; ++j) vT[lane * G3_VS + jh + j] = raw[j]; } }
    LDS_WAIT(); asm volatile("" ::: "memory");
    f32x16 p00, p01, p11;
#pragma unroll
    for (int r = 0; r < 16; ++r) { p00[r] = 0.f; p01[r] = 0.f; p11[r] = 0.f; }
#pragma unroll
    for (int s2 = 0; s2 < 2; ++s2) { p00 = __builtin_amdgcn_mfma_f32_32x32x16_bf16(kf[0][s2], qf[0][s2], p00, 0, 0, 0); p01 = __builtin_amdgcn_mfma_f32_32x32x16_bf16(kf[0][s2], qf[1][s2], p01, 0, 0, 0);
        p11 = __builtin_amdgcn_mfma_f32_32x32x16_bf16(kf[1][s2], qf[1][s2], p11, 0, 0, 0); }
#pragma unroll
    for (int r = 0; r < 16; ++r) { const int j = (r & 3) + 8 * (r >> 2) + 4 * hh; if (j > c) { p00[r] = 0.f; p11[r] = 0.f; } }
    bf16x8v b00[2], b01[2], b11[2];
#pragma unroll
    for (int s2 = 0; s2 < 2; ++s2) { b00[s2] = pack8(p00, s2, 1.f); b01[s2] = pack8(p01, s2, 1.f); b11[s2] = pack8(p11, s2, 1.f); }
    f32x16 o[2][2];
#pragma unroll
    for (int V = 0; V < 2; ++V) { f32x16 a0, a1;
#pragma unroll
        for (int r = 0; r < 16; ++r) { a0[r] = 0.f; a1[r] = 0.f; }
        const float* sp = BS + (size_t)item * 2048 + 32 * V + c;
#pragma unroll
        for (int s2 = 0; s2 < 2; ++s2) { float sv[8];
#pragma unroll
            for (int e = 0; e < 8; ++e) sv[e] = sp[(16 * s2 + 8 * hh + e) * 64];
            v4u w; w.x = pkbf(sv[0], sv[1]); w.y = pkbf(sv[2], sv[3]); w.z = pkbf(sv[4], sv[5]); w.w = pkbf(sv[6], sv[7]); const bf16x8v sa = __builtin_bit_cast(bf16x8v, w);
            a0 = __builtin_amdgcn_mfma_f32_32x32x16_bf16(sa, qf[0][s2], a0, 0, 0, 0); a1 = __builtin_amdgcn_mfma_f32_32x32x16_bf16(sa, qf[1][s2], a1, 0, 0, 0);
            const LAS bf16* vr = vT + (32 * V + c) * G3_VS + 16 * s2 + 4 * hh;
            const v2u l0 = *(const LAS v2u*)vr, h0 = *(const LAS v2u*)(vr + 8), l1 = *(const LAS v2u*)(vr + 32), h1 = *(const LAS v2u*)(vr + 40);
            const bf16x8v va0 = __builtin_bit_cast(bf16x8v, (v4u){l0.x, l0.y, h0.x, h0.y}), va1 = __builtin_bit_cast(bf16x8v, (v4u){l1.x, l1.y, h1.x, h1.y});
            a0 = __builtin_amdgcn_mfma_f32_32x32x16_bf16(va0, b00[s2], a0, 0, 0, 0);
            a1 = __builtin_amdgcn_mfma_f32_32x32x16_bf16(va0, b01[s2], a1, 0, 0, 0); a1 = __builtin_amdgcn_mfma_f32_32x32x16_bf16(va1, b11[s2], a1, 0, 0, 0); }
        o[V][0] = a0; o[V][1] = a1; }
    v2u zw8[2][8]; f32x4 gn8[8];
#pragma unroll
    for (int q = 0; q < 8; ++q) { gn8[q] = *(const f32x4*)(gnorm + 32 * (q >> 2) + 8 * (q & 3) + 4 * hh);
#pragma unroll
        for (int I = 0; I < 2; ++I) zw8[I][q] = *(const v2u*)(ZBp + (t0 + 32 * I + c) * ZBW + ZB_GOG + h * 64 + 4 * hh + 32 * (q >> 2) + 8 * (q & 3)); }
#pragma unroll
    for (int I = 0; I < 2; ++I) { float ss = 0.f;
#pragma unroll
        for (int r = 0; r < 16; ++r) ss += o[0][I][r] * o[0][I][r] + o[1][I][r] * o[1][I][r];
        ss += __shfl_xor(ss, 32);
        const float rinv = 1.0f / sqrtf(ss * (1.f / 64.f) + EPS); const size_t t = t0 + 32 * I + c;
        bf16* op = BRp + t * 1024 + 512 + h * 64 + 4 * hh;
#pragma unroll
        for (int V = 0; V < 2; ++V)
#pragma unroll
            for (int g = 0; g < 4; ++g) { const int v0 = 32 * V + 8 * g; const v2u zw = zw8[I][V * 4 + g]; const f32x4 gn = gn8[V * 4 + g];
                const float z0 = bflo(zw.x), z1 = bfhi(zw.x), z2 = bflo(zw.y), z3 = bfhi(zw.y);
                v2u ow; ow.x = pkbf(o[V][I][4 * g] * rinv * gn[0] * z0 * sigmoidf_(z0), o[V][I][4 * g + 1] * rinv * gn[1] * z1 * sigmoidf_(z1));
                ow.y = pkbf(o[V][I][4 * g + 2] * rinv * gn[2] * z2 * sigmoidf_(z2), o[V][I][4 * g + 3] * rinv * gn[3] * z3 * sigmoidf_(z3));
                *(v2u*)(op + v0) = ow; } }
    LDS_WAIT(); asm volatile("" ::: "memory");
}
__device__ __forceinline__ void dn3_item(int item, int lane, const bf16* QD, const bf16* AT, const bf16* SNT, const bf16* WT, const bf16* ZBp, const float* gnp, bf16* BRp) {
    const int chunk = item >> 2, h = item & 3, c = lane & 31, hh = lane >> 5; const size_t t0 = (size_t)chunk * 64, ib = (size_t)item * 4096;
    f32x16 o[2][2];
#pragma unroll
    for (int I = 0; I < 2; ++I)
#pragma unroll
        for (int J = 0; J < 2; ++J)
#pragma unroll
            for (int r = 0; r < 16; ++r) o[I][J][r] = 0.f;
#pragma unroll
    for (int s4 = 0; s4 < 4; ++s4) { bf16x8v qa[2], aa[2], sb[2], ub[2];
#pragma unroll
        for (int I = 0; I < 2; ++I) { const size_t off = ib + (32 * I + c) * 64 + 16 * s4 + 8 * hh;
            qa[I] = __builtin_bit_cast(bf16x8v, *(const v4u*)(QD + off)); aa[I] = __builtin_bit_cast(bf16x8v, *(const v4u*)(AT + off));
            sb[I] = __builtin_bit_cast(bf16x8v, *(const v4u*)(SNT + off)); ub[I] = __builtin_bit_cast(bf16x8v, *(const v4u*)(WT + off)); }
#pragma unroll
        for (int I = 0; I < 2; ++I)
#pragma unroll
            for (int J = 0; J < 2; ++J) { o[I][J] = __builtin_amdgcn_mfma_f32_32x32x16_bf16(qa[I], sb[J], o[I][J], 0, 0, 0); o[I][J] = __builtin_amdgcn_mfma_f32_32x32x16_bf16(aa[I], ub[J], o[I][J], 0, 0, 0); } }
    const float gn0 = gnp[c], gn1 = gnp[32 + c];
    unsigned short zr[2][16][2];
#pragma unroll
    for (int I = 0; I < 2; ++I)
#pragma unroll
        for (int r = 0; r < 16; ++r) { const bf16* zp = ZBp + (t0 + 32 * I + (r & 3) + 8 * (r >> 2) + 4 * hh) * ZBW + ZB_DZ + h * 64 + c; zr[I][r][0] = zp[0]; zr[I][r][1] = zp[32]; }
#pragma unroll
    for (int I = 0; I < 2; ++I)
#pragma unroll
        for (int r = 0; r < 16; ++r) { float ss = o[I][0][r] * o[I][0][r] + o[I][1][r] * o[I][1][r];
            ss = dpp_row_sum(ss); ss += __shfl_xor(ss, 16);
            const float rinv = 1.0f / sqrtf(ss * (1.f / 64.f) + EPS);
            const size_t t = t0 + 32 * I + (r & 3) + 8 * (r >> 2) + 4 * hh;
            bf16* op = BRp + t * 1024 + 768 + h * 64 + c;
            const float z0 = bf2f(zr[I][r][0]), z1 = bf2f(zr[I][r][1]);
            op[0] = (bf16)f2bf(o[I][0][r] * rinv * gn0 * z0 * sigmoidf_(z0)); op[32] = (bf16)f2bf(o[I][1][r] * rinv * gn1 * z1 * sigmoidf_(z1)); }
}

constexpr int AT_KS = 104, AT_VS = 68, AT_KBYTES = 64 * AT_KS * 2, AT_VBYTES = 64 * AT_VS * 2, AT_STAGE = AT_KBYTES + AT_VBYTES;
__device__ __forceinline__ void attn_unit(LAS unsigned char* lds, int b, int h, int qb, int tid, const bf16* Qp, const bf16* Kp, const bf16* VTp, bf16* BRp) {
    const int lane = tid & 63, wave = __builtin_amdgcn_readfirstlane(tid >> 6), c = lane & 31, hh = lane >> 5;
    const bool grpB = wave >= 4;
    const int qpos = 256 * qb + 32 * wave + c; const size_t tq = (size_t)b * SEQ + qpos;
    const float c2 = 0.10206207261596577f * 1.4426950408889634f;
    bf16x8v qf[6];
#pragma unroll
    for (int s6 = 0; s6 < 6; ++s6) qf[s6] = __builtin_bit_cast(bf16x8v, *(const v4u*)(Qp + (tq * 4 + h) * 96 + 16 * s6 + 8 * hh));
    f32x16 o0, o1;
#pragma unroll
    for (int r = 0; r < 16; ++r) { o0[r] = 0.f; o1[r] = 0.f; }
    float mrun = -INFINITY, lrun = 0.f;
    const int nt = 4 * (qb + 1);
    const int kr0 = tid / 12, kc0 = tid - 12 * kr0, kr1 = (tid + 512) / 12, kc1 = (tid + 512) - 12 * kr1; const bool k2 = tid < 256;
    const int vr = tid >> 3, vc = tid & 7;
    const bf16* kg = Kp + ((size_t)b * SEQ * 4 + h) * 96; const bf16* vg = VTp + ((size_t)(b * 4 + h) * 64 + vr) * SEQ + 8 * vc;
    v4u sk0, sk1, sv;
    sk0 = *(const v4u*)(kg + (size_t)kr0 * 384 + 8 * kc0); if (k2) sk1 = *(const v4u*)(kg + (size_t)kr1 * 384 + 8 * kc1); sv = *(const v4u*)vg;
    { LAS unsigned char* st = lds; *(LAS v4u*)(st + kr0 * (AT_KS * 2) + 16 * kc0) = sk0; if (k2) *(LAS v4u*)(st + kr1 * (AT_KS * 2) + 16 * kc1) = sk1;
      LAS unsigned char* vt = st + AT_KBYTES + vr * (AT_VS * 2) + 16 * vc; *(LAS v2u*)vt = (v2u){sv.x, sv.y}; *(LAS v2u*)(vt + 8) = (v2u){sv.z, sv.w}; }
    __syncthreads();
    bf16x8v pf[4]; bool pend = false; int pstage = 0;
#define AT_PV(stg) do { const LAS unsigned char* vtb_ = lds + (stg) * AT_STAGE + AT_KBYTES + c * (AT_VS * 2) + 8 * hh; \
        _Pragma("unroll") for (int kb = 0; kb < 2; ++kb) _Pragma("unroll") for (int s2 = 0; s2 < 2; ++s2) { const LAS unsigned char* va = vtb_ + (32 * kb + 16 * s2) * 2; \
            const v2u a0l = *(const LAS v2u*)va, a0h = *(const LAS v2u*)(va + 16), a1l = *(const LAS v2u*)(va + 32 * (AT_VS * 2)), a1h = *(const LAS v2u*)(va + 32 * (AT_VS * 2) + 16); \
            const bf16x8v av0 = __builtin_bit_cast(bf16x8v, (v4u){a0l.x, a0l.y, a0h.x, a0h.y}), av1 = __builtin_bit_cast(bf16x8v, (v4u){a1l.x, a1l.y, a1h.x, a1h.y}); \
            o0 = __builtin_amdgcn_mfma_f32_32x32x16_bf16(av0, pf[2 * kb + s2], o0, 0, 0, 0); o1 = __builtin_amdgcn_mfma_f32_32x32x16_bf16(av1, pf[2 * kb + s2], o1, 0, 0, 0); } } while (0)
    int stg = 0;
    for (int t = 0; t < nt; ++t) {
        const bool more = (t + 1 < nt);
        if (more) { const size_t k0 = (size_t)(t + 1) * 64; sk0 = *(const v4u*)(kg + (k0 + kr0) * 384 + 8 * kc0); if (k2) sk1 = *(const v4u*)(kg + (k0 + kr1) * 384 + 8 * kc1); sv = *(const v4u*)(vg + k0); }
        if (pend) { AT_PV(pstage); pend = false; }
        const LAS unsigned char* st = lds + stg * AT_STAGE;
        const int tt = t - (nt - 4);
        const bool active = (tt < 0) || (64 * tt <= 32 * wave + 31);
        if (active) {
            f32x16 p0, p1;
            { const bf16x8v a0 = *(const LAS bf16x8v*)(st + c * (AT_KS * 2) + 16 * hh), a1 = *(const LAS bf16x8v*)(st + (32 + c) * (AT_KS * 2) + 16 * hh);
              const f32x16 zz = {0.f, 0.f, 0.f, 0.f, 0.f, 0.f, 0.f, 0.f, 0.f, 0.f, 0.f, 0.f, 0.f, 0.f, 0.f, 0.f};
              p0 = __builtin_amdgcn_mfma_f32_32x32x16_bf16(a0, qf[0], zz, 0, 0, 0); p1 = __builtin_amdgcn_mfma_f32_32x32x16_bf16(a1, qf[0], zz, 0, 0, 0); }
#pragma unroll
            for (int s6 = 1; s6 < 6; ++s6) { const bf16x8v a0 = *(const LAS bf16x8v*)(st + c * (AT_KS * 2) + 32 * s6 + 16 * hh), a1 = *(const LAS bf16x8v*)(st + (32 + c) * (AT_KS * 2) + 32 * s6 + 16 * hh);
                p0 = __builtin_amdgcn_mfma_f32_32x32x16_bf16(a0, qf[s6], p0, 0, 0, 0); p1 = __builtin_amdgcn_mfma_f32_32x32x16_bf16(a1, qf[s6], p1, 0, 0, 0); }
            if (tt >= 0 && (64 * tt + 63 > 32 * wave)) { const int kb0 = 64 * t + 4 * hh;
#pragma unroll
                for (int r = 0; r < 16; ++r) { const int key = kb0 + (r & 3) + 8 * (r >> 2); if (key > qpos) p0[r] = -INFINITY; if (key + 32 > qpos) p1[r] = -INFINITY; } }
            float tmax = fmaxf(p0[0], p1[0]);
#pragma unroll
            for (int r = 1; r < 16; ++r) tmax = fmaxf(tmax, fmaxf(p0[r], p1[r]));
            tmax = fmaxf(tmax, __shfl_xor(tmax, 32));
            const float mnew = fmaxf(mrun, tmax); const float mc = mnew * c2;
            if (__any(mnew > mrun)) { const float alpha = __builtin_amdgcn_exp2f((mrun - mnew) * c2); lrun *= alpha; o0 = o0 * alpha; o1 = o1 * alpha; }
            float rs = 0.f;
#pragma unroll
            for (int r = 0; r < 16; ++r) { p0[r] = __builtin_amdgcn_exp2f(p0[r] * c2 - mc); p1[r] = __builtin_amdgcn_exp2f(p1[r] * c2 - mc); rs += p0[r] + p1[r]; }
            rs += __shfl_xor(rs, 32);
            lrun += rs; mrun = mnew;
            pf[0] = pack8(p0, 0, 1.f); pf[1] = pack8(p0, 1, 1.f); pf[2] = pack8(p1, 0, 1.f); pf[3] = pack8(p1, 1, 1.f);
            if (grpB) { pend = true; pstage = stg; } else { AT_PV(stg); }
        }
        const int nstg = (stg == 2) ? 0 : stg + 1;
        if (more) { LAS unsigned char* sn = lds + nstg * AT_STAGE; *(LAS v4u*)(sn + kr0 * (AT_KS * 2) + 16 * kc0) = sk0; if (k2) *(LAS v4u*)(sn + kr1 * (AT_KS * 2) + 16 * kc1) = sk1;
            LAS unsigned char* vt = sn + AT_KBYTES + vr * (AT_VS * 2) + 16 * vc; *(LAS v2u*)vt = (v2u){sv.x, sv.y}; *(LAS v2u*)(vt + 8) = (v2u){sv.z, sv.w}; }
        stg = nstg;
        __syncthreads();
    }
    if (pend) { AT_PV(pstage); }
#undef AT_PV
    const float il = 1.0f / lrun; bf16* op = BRp + tq * 1024 + h * 64 + 4 * hh;
#pragma unroll
    for (int g = 0; g < 4; ++g) { v2u w0, w1; w0.x = pkbf(o0[4 * g] * il, o0[4 * g + 1] * il); w0.y = pkbf(o0[4 * g + 2] * il, o0[4 * g + 3] * il); w1.x = pkbf(o1[4 * g] * il, o1[4 * g + 1] * il); w1.y = pkbf(o1[4 * g + 2] * il, o1[4 * g + 3] * il);
        *(v2u*)(op + 8 * g) = w0; *(v2u*)(op + 32 + 8 * g) = w1; }
    __syncthreads();
}
constexpr int XA_RS = 264, XA_TB = 64 * XA_RS * 2;
__device__ __forceinline__ void xattn_unit(LAS unsigned char* lds, int b, int h, int qb, int tid, const bf16* XQp, const bf16* KXp, const bf16* VXTp, bf16* XOp, const float* ssq16) {
    const int lane = tid & 63, wave = __builtin_amdgcn_readfirstlane(tid >> 6), c = lane & 31, hh = lane >> 5;
    const size_t tq = (size_t)b * SEQ + 256 * qb + 32 * wave + c;
    const float c2 = 0.0625f * 1.4426950408889634f * row_rscale(ssq16, tq);
    const bf16* qp = XQp + tq * 1024 + h * 256 + 8 * hh;
    const int ch = tid & 31, r0 = tid >> 5;
#define XA_STAGE2(j0, isv) do { v4u st8[2][4]; _Pragma("unroll") for (int jj = 0; jj < 2; ++jj) { const int j = (j0) + jj; \
            const bf16* base = (isv) ? VXTp + ((size_t)((b * 4 + h) * 256 + 64 * j)) * 256 : KXp + ((size_t)(b * 256 + 64 * j)) * 1024 + h * 256; const int rs = (isv) ? 256 : 1024; \
            _Pragma("unroll") for (int i = 0; i < 4; ++i) st8[jj][i] = *(const v4u*)(base + (size_t)(r0 + 16 * i) * rs + 8 * ch); } \
        _Pragma("unroll") for (int jj = 0; jj < 2; ++jj) { LAS unsigned char* sb = lds + ((j0) + jj) * XA_TB; _Pragma("unroll") for (int i = 0; i < 4; ++i) *(LAS v4u*)(sb + (r0 + 16 * i) * (XA_RS * 2) + 16 * ch) = st8[jj][i]; } } while (0)
    XA_STAGE2(0, false); XA_STAGE2(2, false);
    __syncthreads();
    f32x16 p[8];
#pragma unroll
    for (int j = 0; j < 8; ++j)
#pragma unroll
        for (int r = 0; r < 16; ++r) p[j][r] = 0.f;
#pragma unroll
    for (int sc = 0; sc < 4; ++sc) { bf16x8v qf[4];
#pragma unroll
        for (int i = 0; i < 4; ++i) qf[i] = __builtin_bit_cast(bf16x8v, *(const v4u*)(qp + 16 * (4 * sc + i)));
#pragma unroll
        for (int kb = 0; kb < 8; ++kb) { const LAS unsigned char* kt = lds + (kb >> 1) * XA_TB + (32 * (kb & 1) + c) * (XA_RS * 2) + 32 * (4 * sc) + 16 * hh;
#pragma unroll
            for (int i = 0; i < 4; ++i) p[kb] = __builtin_amdgcn_mfma_f32_32x32x16_bf16(*(const LAS bf16x8v*)(kt + 32 * i), qf[i], p[kb], 0, 0, 0); } }
    float mx = p[0][0];
#pragma unroll
    for (int j = 0; j < 8; ++j)
#pragma unroll
        for (int r = 0; r < 16; ++r) mx = fmaxf(mx, p[j][r]);
    mx = fmaxf(mx, __shfl_xor(mx, 32));
    const float mc = mx * c2; float rs = 0.f;
#pragma unroll
    for (int j = 0; j < 8; ++j)
#pragma unroll
        for (int r = 0; r < 16; ++r) { p[j][r] = __builtin_amdgcn_exp2f(p[j][r] * c2 - mc); rs += p[j][r]; }
    rs += __shfl_xor(rs, 32);
    const float il = 1.0f / rs;
    bf16x8v pf[16];
#pragma unroll
    for (int kb = 0; kb < 8; ++kb) { pf[2 * kb] = pack8(p[kb], 0, 1.f); pf[2 * kb + 1] = pack8(p[kb], 1, 1.f); }
    __syncthreads();
    XA_STAGE2(0, true); XA_STAGE2(2, true);
    __syncthreads();
    bf16* op = XOp + tq * 1024 + h * 256 + 4 * hh;
#pragma unroll 1
    for (int j = 0; j < 4; ++j) { const LAS unsigned char* st = lds + j * XA_TB;
        f32x16 o0, o1;
#pragma unroll
        for (int r = 0; r < 16; ++r) { o0[r] = 0.f; o1[r] = 0.f; }
#pragma unroll
        for (int ks = 0; ks < 16; ++ks) { const LAS unsigned char* va = st + c * (XA_RS * 2) + 32 * ks + 8 * hh;
            const v2u a0l = *(const LAS v2u*)va, a0h = *(const LAS v2u*)(va + 16), a1l = *(const LAS v2u*)(va + 32 * (XA_RS * 2)), a1h = *(const LAS v2u*)(va + 32 * (XA_RS * 2) + 16);
            const bf16x8v av0 = __builtin_bit_cast(bf16x8v, (v4u){a0l.x, a0l.y, a0h.x, a0h.y}), av1 = __builtin_bit_cast(bf16x8v, (v4u){a1l.x, a1l.y, a1h.x, a1h.y});
            o0 = __builtin_amdgcn_mfma_f32_32x32x16_bf16(av0, pf[ks], o0, 0, 0, 0); o1 = __builtin_amdgcn_mfma_f32_32x32x16_bf16(av1, pf[ks], o1, 0, 0, 0); }
        bf16* oq = op + 64 * j;
#pragma unroll
        for (int g = 0; g < 4; ++g) { v2u w0, w1; w0.x = pkbf(o0[4 * g] * il, o0[4 * g + 1] * il); w0.y = pkbf(o0[4 * g + 2] * il, o0[4 * g + 3] * il); w1.x = pkbf(o1[4 * g] * il, o1[4 * g + 1] * il); w1.y = pkbf(o1[4 * g + 2] * il, o1[4 * g + 3] * il);
            *(v2u*)(oq + 8 * g) = w0; *(v2u*)(oq + 32 + 8 * g) = w1; } }
    __syncthreads();
#undef XA_STAGE2
}

constexpr int SG_RS = 136;
__device__ __forceinline__ void sg_chunk(LAS unsigned char* lds, int chunk, int tid, const bf16* ZAp, const bf16* Wm, const float* lng, const float* lnb, const float* sgb, bf16* BRp) {
    const int lane = tid & 63, wave = __builtin_amdgcn_readfirstlane(tid >> 6); const size_t t0 = (size_t)chunk * 128;
    LAS bf16* vT = (LAS bf16*)lds;
#pragma unroll 1
    for (int r0 = wave; r0 < 128; r0 += 32) { unsigned short raw[4][4];
#pragma unroll
        for (int q = 0; q < 4; ++q)
#pragma unroll
            for (int i = 0; i < 4; ++i) raw[q][i] = ZAp[(t0 + r0 + 8 * q) * 1024 + Z_SGV + lane + 64 * i];
#pragma unroll
        for (int q = 0; q < 4; ++q) { const int r = r0 + 8 * q; float gv[4]; float sm = 0.f;
#pragma unroll
            for (int i = 0; i < 4; ++i) { gv[i] = gelu_tanh(bf2f(raw[q][i])); sm += gv[i]; }
            const float mean = wave_sum(sm) * (1.f / 256.f); float qq = 0.f;
#pragma unroll
            for (int i = 0; i < 4; ++i) { gv[i] -= mean; qq += gv[i] * gv[i]; }
            const float rstd = 1.0f / sqrtf(wave_sum(qq) * (1.f / 256.f) + EPS);
#pragma unroll
            for (int i = 0; i < 4; ++i) { const int ch = lane + 64 * i; vT[ch * SG_RS + r] = (bf16)f2bf(gv[i] * rstd * lng[ch] + lnb[ch]); } } }
    __syncthreads();
    { const int g = wave >> 1, ct = wave & 1, c = lane & 31, hh = lane >> 5; const int ch = g * 64 + ct * 32 + c;
      f32x16 acc[4];
#pragma unroll
      for (int I = 0; I < 4; ++I)
#pragma unroll
          for (int r = 0; r < 16; ++r) acc[I][r] = 0.f;
#pragma unroll
      for (int s = 0; s < 8; ++s) { const bf16x8v bfr = *(const LAS bf16x8v*)(vT + ch * SG_RS + 16 * s + 8 * hh);
#pragma unroll
          for (int I = 0; I < 4; ++I) if (16 * s < 32 * (I + 1)) { const bf16x8v afr = __builtin_bit_cast(bf16x8v, *(const v4u*)(Wm + ((size_t)g * 128 + 32 * I + c) * 128 + 16 * s + 8 * hh));
              acc[I] = __builtin_amdgcn_mfma_f32_32x32x16_bf16(afr, bfr, acc[I], 0, 0, 0); } }
#pragma unroll
      for (int I = 0; I < 4; ++I) { unsigned short ur[16];
#pragma unroll
          for (int r = 0; r < 16; ++r) { const int i = 32 * I + (r & 3) + 8 * (r >> 2) + 4 * hh; ur[r] = ZAp[(t0 + i) * 1024 + Z_SGU + ch]; }
#pragma unroll
          for (int r = 0; r < 16; ++r) { const int i = 32 * I + (r & 3) + 8 * (r >> 2) + 4 * hh; const size_t t = t0 + i;
              const float uu = gelu_tanh(bf2f(ur[r])); BRp[t * 1024 + 256 + ch] = (bf16)f2bf(uu * (acc[I][r] + sgb[g * 128 + i])); } } }
    __syncthreads();
}

constexpr int P6_RS = 528, P6_TS = 144;
__device__ __forceinline__ void p6_phase(LAS unsigned char* lds, int vcu, int G, int tid, const bf16* BRp, const bf16* Wp, bf16* Pp) {
    const int lane = tid & 63, wave = __builtin_amdgcn_readfirstlane(tid >> 6), c = lane & 31, hh = lane >> 5;
    const int nper = G >= 8 ? G / 8 : 1;
    if (G >= 8 && vcu >= 8 * nper) return;
    const int idx = G >= 8 ? vcu / 8 : 0;
    constexpr int NB64 = T / 64, ABUF = 64 * P6_RS;
    for (int cmb = (G >= 8 ? vcu % 8 : vcu); cmb < 8; cmb += (G >= 8 ? 8 : G)) {
        const int gate = cmb >> 1, slab = cmb & 1;
        bf16x8v wf[2][16];
#pragma unroll
        for (int nb = 0; nb < 2; ++nb)
#pragma unroll
            for (int st = 0; st < 16; ++st) wf[nb][st] = __builtin_bit_cast(bf16x8v, *(const v4u*)(Wp + ((size_t)gate * 1024 + slab * 512 + wave * 64 + nb * 32 + c) * 256 + 16 * st + 8 * hh));
        const bf16* src = BRp + (size_t)(tid >> 5) * 1024 + 256 * gate + 8 * (tid & 31);
        v4u g[4];
#pragma unroll
        for (int q = 0; q < 4; ++q) g[q] = *(const v4u*)(src + (size_t)(64 * idx + 16 * q) * 1024);
        __syncthreads();
        { LAS unsigned char* wp = lds + (tid >> 5) * P6_RS + (tid & 31) * 16;
#pragma unroll
          for (int q = 0; q < 4; ++q) *(LAS v4u*)(wp + 16 * q * P6_RS) = g[q]; }
        __syncthreads();
        int buf = 0;
        for (int rb = idx; rb < NB64; rb += nper) {
            const bool more = rb + nper < NB64;
            if (more) {
#pragma unroll
                for (int q = 0; q < 4; ++q) g[q] = *(const v4u*)(src + (size_t)(64 * (rb + nper) + 16 * q) * 1024); }
#pragma unroll 1
            for (int tg = 0; tg < 2; ++tg) {
                const LAS unsigned char* xb = lds + buf * ABUF + (32 * tg + c) * P6_RS + 16 * hh;
                f32x16 a0, a1;
#pragma unroll
                for (int r = 0; r < 16; ++r) { a0[r] = 0.f; a1[r] = 0.f; }
#pragma unroll
                for (int h8 = 0; h8 < 2; ++h8) { bf16x8v xf[8];
#pragma unroll
                    for (int u = 0; u < 8; ++u) xf[u] = *(const LAS bf16x8v*)(xb + 32 * (8 * h8 + u));
                    __builtin_amdgcn_sched_barrier(0);
#pragma unroll
                    for (int u = 0; u < 8; ++u) { a0 = __builtin_amdgcn_mfma_f32_32x32x16_bf16(wf[0][8 * h8 + u], xf[u], a0, 0, 0, 0); a1 = __builtin_amdgcn_mfma_f32_32x32x16_bf16(wf[1][8 * h8 + u], xf[u], a1, 0, 0, 0); } }
                { char* pb_ = (char*)Pp + (((((size_t)rb * 4 + gate) * 128 + slab * 64 + wave * 8) * 64) + 32 * tg + c) * 16;
#pragma unroll
                  for (int nb = 0; nb < 2; ++nb)
#pragma unroll
                      for (int p = 0; p < 2; ++p) { const f32x16& av = nb ? a1 : a0; const int q0 = 2 * p, q1 = 2 * p + 1;
                          const unsigned x0 = pkbf(av[4 * q0], av[4 * q0 + 1]), y0 = pkbf(av[4 * q0 + 2], av[4 * q0 + 3]), x1 = pkbf(av[4 * q1], av[4 * q1 + 1]), y1 = pkbf(av[4 * q1 + 2], av[4 * q1 + 3]);
                          const auto sx = __builtin_amdgcn_permlane32_swap(x0, x1, false, false), sy = __builtin_amdgcn_permlane32_swap(y0, y1, false, false);
                          v4u o; o.x = sx[0]; o.y = sy[0]; o.z = sx[1]; o.w = sy[1];
                          *(v4u*)(pb_ + (size_t)(nb * 4 + 2 * p + hh) * 64 * 16) = o; } } }
            if (more) { LAS unsigned char* wp = lds + (buf ^ 1) * ABUF + (tid >> 5) * P6_RS + (tid & 31) * 16;
#pragma unroll
                for (int q = 0; q < 4; ++q) *(LAS v4u*)(wp + 16 * q * P6_RS) = g[q]; }
            buf ^= 1;
            __syncthreads();
        }
    }
}

struct Args { const void* in[32]; float* out; unsigned char* ws; int ph_lo, ph_hi; };
constexpr int NPH_L = 15, NPHASES = DEPTH * NPH_L + 1;

#ifndef MK_N_LAUNCHES
#define MK_N_LAUNCHES 1
#endif

#define KIN(k) (apl->in[k])
#define x_in ((const float*)(const GAS float*)KIN(0))
#define mem ((const float*)(const GAS float*)KIN(1))
#define positions ((const int*)(const GAS int*)KIN(2))
#define norm_mix ((const float*)(const GAS float*)KIN(3))
#define w_in ((const float*)(const GAS float*)KIN(4))
#define mla_nq ((const float*)(const GAS float*)KIN(5))
#define mla_nkv ((const float*)(const GAS float*)KIN(6))
#define mla_wuq ((const float*)(const GAS float*)KIN(7))
#define mla_wukv ((const float*)(const GAS float*)KIN(8))
#define sg_ln_g ((const float*)(const GAS float*)KIN(9))
#define sg_ln_b ((const float*)(const GAS float*)KIN(10))
#define sg_w ((const float*)(const GAS float*)KIN(11))
#define sg_b ((const float*)(const GAS float*)KIN(12))
#define gla_wg ((const float*)(const GAS float*)KIN(13))
#define gla_bg ((const float*)(const GAS float*)KIN(14))
#define gla_norm ((const float*)(const GAS float*)KIN(15))
#define dn_conv ((const float*)(const GAS float*)KIN(16))
#define dn_alog ((const float*)(const GAS float*)KIN(17))
#define dn_dtb ((const float*)(const GAS float*)KIN(18))
#define dn_norm ((const float*)(const GAS float*)KIN(19))
#define w_branch ((const float*)(const GAS float*)KIN(20))
#define w_out ((const float*)(const GAS float*)KIN(21))
#define norm_xattn ((const float*)(const GAS float*)KIN(22))
#define norm_mem ((const float*)(const GAS float*)KIN(23))
#define xwq ((const float*)(const GAS float*)KIN(24))
#define xwk ((const float*)(const GAS float*)KIN(25))
#define xwv ((const float*)(const GAS float*)KIN(26))
#define xwo ((const float*)(const GAS float*)KIN(27))
#define norm_mlp ((const float*)(const GAS float*)KIN(28))
#define w_up ((const float*)(const GAS float*)KIN(29))
#define w_down ((const float*)(const GAS float*)KIN(30))
#define norm_final ((const float*)(const GAS float*)KIN(31))
#define ROPEC ((float*)(wsl + WS_ROPEC))
#define ROPES ((float*)(wsl + WS_ROPES))
#define KX ((bf16*)(wsl + WS_KX))
#define VX ((bf16*)(wsl + WS_VX))
#define MEMN ((bf16*)(wsl + WS_MEMN))
#define Wz ((bf16*)(wsl + WS_WZ))
#define Wmla ((bf16*)(wsl + WS_WMLA))
#define Wmrg ((bf16*)(wsl + WS_WMRG))
#define Wpj ((bf16*)(wsl + WS_WMRG + 8 * MiB))
#define PJ ((bf16*)(wsl + WS_PJ))
#define Wout ((bf16*)(wsl + WS_WOUT))
#define Wxq ((bf16*)(wsl + WS_WXQ))
#define Wxk ((bf16*)(wsl + WS_WXK))
#define Wxv ((bf16*)(wsl + WS_WXV))
#define Wxo ((bf16*)(wsl + WS_WXO))
#define Wup ((bf16*)(wsl + WS_WUP))
#define Wdn ((bf16*)(wsl + WS_WDN))
#define HB ((bf16*)(wsl + WS_HB))
#define BR ((bf16*)(wsl + WS_BR))
#define ZA ((bf16*)(wsl + WS_ZA))
#define ZB ((bf16*)(wsl + WS_ZB))
#define ZF ((float*)(wsl + WS_ZF))
#define SSQ ((float*)(wsl + WS_SSQ))
#define SS16 ((float*)(wsl + WS_SS16))
#define SS16B ((float*)(wsl + WS_SS16B))
#define R1 ((float*)(wsl + WS_R1))
#define WSM ((bf16*)(wsl + WS_WSM))
#define QB ((bf16*)(wsl + WS_Q))
#define KB ((bf16*)(wsl + WS_K))
#define VB ((bf16*)(wsl + WS_V))
#define MG ((bf16*)(wsl + WS_MG))
#define XQ ((bf16*)(wsl + WS_XQ))
#define XO ((bf16*)(wsl + WS_XO))
#define HID ((bf16*)(wsl + WS_HID))
#define XR (args.out)
#define OUTB ((unsigned char*)(GAS unsigned char*)args.out)
#define XCb ((bf16*)(OUTB + 0 * MiB))
#define WTb ((bf16*)(OUTB + 16 * MiB))
#define KDTb ((bf16*)(OUTB + 32 * MiB))
#define QDb ((bf16*)(OUTB + 48 * MiB))
#define ATb ((bf16*)(wsl + WS_AT))
#define BSb ((float*)(wsl + WS_BS))
#define EGb ((float*)(wsl + WS_EG))
#define GLb ((float*)(wsl + WS_GL))
#define SNTb ((bf16*)(wsl + WS_SNT))
__global__ void __launch_bounds__(NWAVES * 64, 2) skel_fwd(Args args) {
    extern __shared__ __attribute__((aligned(16))) unsigned char lds_raw[];
    Frame F;
    F.lds = (LAS unsigned char*)lds_raw;
    volatile LAS unsigned* MISC = (volatile LAS unsigned*)(F.lds + MISC_OFF);
    F.tid = threadIdx.x; F.lane = F.tid & 63; F.wave = __builtin_amdgcn_readfirstlane(F.tid >> 6);
    F.G = gridDim.x; { const int bx = blockIdx.x; F.vcu = (F.G % 8 == 0) ? (bx % 8) * (F.G / 8) + bx / 8 : bx; }
    unsigned char* ws = args.ws;
    gu32* ctl = (gu32*)(ws + WS_CTL);
    for (int u = F.tid; u < (LDS_BYTES - LDSCTL_OFF) / 4; u += NWAVES * 64) ((LAS unsigned*)(F.lds + LDSCTL_OFF))[u] = 0u;
    __syncthreads();
    const int lo = args.ph_lo, hi = args.ph_hi;
    const bool use_bar = (hi - lo) > 1;
    XcdBarrier bar; bar.bar = (unsigned*)(ctl + CW_BAR); bar.x = 0; bar.st = nullptr;
    if (use_bar) bar = xcd_barrier_post((unsigned*)(ctl + CW_BAR), MISC + 8);
#define IN(k) (lo <= (k) && (k) < hi)
#define SEAM(k) do { if ((k) + 1 < hi) xcd_barrier(bar); } while (0)

    unsigned char* wsl = ws;
    typedef __attribute__((address_space(4))) const Args* KArgP; KArgP apl = (KArgP)__builtin_amdgcn_kernarg_segment_ptr();
    int gw, gtid; const int NGW = F.G * NWAVES, NGT = F.G * NWAVES * 64;
#define PHASE_BEGIN() do { int t_ = threadIdx.x; asm volatile("" : "+v"(t_)); F.tid = t_; F.lane = t_ & 63; F.wave = __builtin_amdgcn_readfirstlane(t_ >> 6); { size_t wo_ = 0; asm volatile("" : "+s"(wo_)); wsl = ws + wo_; apl = (KArgP)((__attribute__((address_space(4))) const char*)__builtin_amdgcn_kernarg_segment_ptr() + wo_); } gw =F.vcu * NWAVES + F.wave; gtid = F.vcu * (NWAVES * 64) + F.tid; } while (0)

    if (IN(0)) { PHASE_BEGIN(); for (int i = gtid; i < T * 16; i += NGT) { float c, s; rope_entry(positions[i >> 4], i & 15, c, s); ROPEC[i] = c; ROPES[i] = s; } }
    for (int l = 0; l < DEPTH; ++l) {
        const int pb = l * NPH_L;

        if (IN(pb + 0)) { PHASE_BEGIN();
            LAS float* scr = (LAS float*)(F.lds + RING_OFF + F.wave * 16384);
            const float* win_l = w_in + (size_t)l * D * INW;
            constexpr int T_WZ = (ZW / 32) * (D / 64), T_MLA = 32 * 8, T_MRG = 128 * 16, T_WP = 4 * 32 * 4, T_SQ = 32 * 16, T_UP = 128 * 16, T_DN = 32 * 64;
            constexpr int NTILES = T_WZ + T_MLA + T_MRG + T_WP + 5 * T_SQ + T_UP + T_DN;
            for (int it = gw; it < NTILES; it += NGW) {
                int r = it;
                if (r < T_WZ) { FnWz f{win_l, norm_mix + l * D}; wprep_tile(f, Wz, D, (r / 16) * 32, (r % 16) * 64, scr, F.lane); continue; } r -= T_WZ;
                if (r < T_MLA) { const int R0 = (r / 8) * 32, k0 = (r % 8) * 64;
                    if (R0 < 384 && k0 < 256) { FnWuq f{mla_wuq + (size_t)l * 256 * 384, mla_nq + l * 256}; wprep_tile(f, Wmla, 512, R0, k0, scr, F.lane); }
                    else if (R0 >= 384 && R0 < 896 && k0 >= 256 && k0 < 384) { FnWukv f{mla_wukv + (size_t)l * 128 * 512, mla_nkv + l * 128}; wprep_tile(f, Wmla, 512, R0, k0, scr, F.lane); }
                    else if (R0 >= 896 && R0 < 928) { FnIdent f; wprep_tile(f, Wmla, 512, R0, k0, scr, F.lane); }
                    else { FnZero f; wprep_tile(f, Wmla, 512, R0, k0, scr, F.lane); }
                    continue; } r -= T_MLA;
                if (r < T_MRG) { FnWmrg f{win_l, norm_mix + l * D}; wprep_tile(f, Wmrg, 1024, (r / 16) * 32, (r % 16) * 64, scr, F.lane); continue; } r -= T_MRG;
                if (r < T_WP) { const int gte = r >> 7, rr2 = r & 127; FnT<false> f{w_branch + ((size_t)l * 4 + gte) * 256 * 1024, 1024, nullptr}; wprep_tile(f, Wpj + (size_t)gte * 1024 * 256, 256, (rr2 >> 2) * 32, (rr2 & 3) * 64, scr, F.lane); continue; } r -= T_WP;
                const float* W; int N, Kd; bf16* dst; const float* gv = nullptr;
                if (r < 5 * T_SQ) { const int w = r / T_SQ; r -= w * T_SQ; N = D; Kd = D;
                    W = (w == 0) ? w_out + (size_t)l * D * D : (w == 1) ? xwq + (size_t)l * D * D : (w == 2) ? xwk + (size_t)l * D * D : (w == 3) ? xwv + (size_t)l * D * D : xwo + (size_t)l * D * D;
                    dst = (w == 0) ? Wout : (w == 1) ? Wxq : (w == 2) ? Wxk : (w == 3) ? Wxv : Wxo; if (w == 1) gv = norm_xattn + l * D; }
                else { r -= 5 * T_SQ; if (r < T_UP) { W = w_up + (size_t)l * D * FF; N = FF; Kd = D; dst = Wup; gv = norm_mlp + l * D; } else { r -= T_UP; W = w_down + (size_t)l * FF * D; N = D; Kd = FF; dst = Wdn; } }
                const int kt = Kd / 64; if (gv) { FnT<true> f{W, N, gv}; wprep_tile(f, dst, Kd, (r / kt) * 32, (r % kt) * 64, scr, F.lane); } else { FnT<false> f{W, N, nullptr}; wprep_tile(f, dst, Kd, (r / kt) * 32, (r % kt) * 64, scr, F.lane); }
            }
            if (l == 0) for (int m = gw; m < T; m += 2 * NGW) {
                const int m2 = m + NGW; const bool two = m2 < T;
                const GAS f32x4* xa = (const GAS f32x4*)(x_in + (size_t)m * D) + F.lane; const GAS f32x4* xb2 = (const GAS f32x4*)(x_in + (size_t)(two ? m2 : m) * D) + F.lane;
                f32x4 va[4], vb[4];
#pragma unroll
                for (int j = 0; j < 4; ++j) { va[j] = xa[64 * j]; vb[j] = xb2[64 * j]; }
                GAS unsigned long long* oa = (GAS unsigned long long*)(HB + (size_t)m * D) + F.lane; GAS unsigned long long* ob = (GAS unsigned long long*)(HB + (size_t)m2 * D) + F.lane; float sa = 0.f, sb = 0.f;
#pragma unroll
                for (int j = 0; j < 4; ++j) { sa += (va[j].x * va[j].x + va[j].y * va[j].y) + (va[j].z * va[j].z + va[j].w * va[j].w); sb += (vb[j].x * vb[j].x + vb[j].y * vb[j].y) + (vb[j].z * vb[j].z + vb[j].w * vb[j].w);
                    oa[64 * j] = (unsigned long long)pk2(va[j].x, va[j].y) | ((unsigned long long)pk2(va[j].z, va[j].w) << 32);
                    if (two) ob[64 * j] = (unsigned long long)pk2(vb[j].x, vb[j].y) | ((unsigned long long)pk2(vb[j].z, vb[j].w) << 32); }
                sa = wave_sum(sa); sb = wave_sum(sb);
                if (F.lane == 0) { R1[m] = 1.0f / sqrtf(sa * (1.f / 1024.f) + EPS); if (two) R1[m2] = 1.0f / sqrtf(sb * (1.f / 1024.f) + EPS); } }
            else for (int m = gtid; m < T; m += NGT) R1[m] = row_rscale(SS16, (size_t)m);
            for (int m = gw; m < MT; m += NGW) rms_row_bf16(mem + (size_t)m * D, norm_mem + l * D, MEMN + (size_t)m * D, F.lane);
            for (int i = gtid; i < 4 * 128 * 128; i += NGT) { const int ii = (i >> 7) & 127, jj = i & 127; WSM[i] = (bf16)f2bf(jj <= ii ? sg_w[(size_t)l * 65536 + i] : 0.f); }
            SEAM(pb + 0);
        }
        if (IN(pb + 1)) { PHASE_BEGIN();
            pg8::Gemm g{HB, nullptr, Wz, D, T, ZW, D, 1 << 20, 0}; pg8::StaticOrder S; S.init(T, ZW, F.G, (int)blockIdx.x);
            pg8::EpiZin E{ZA, ZB, SSQ, ZF, R1};
            pg8::gemm_phase<pg8::EpiZin, pg8::StaticOrder, true, true>(F.lds + RING_OFF, g, S, E);
            PHASE_BEGIN();
            { pg8::Gemm g{MEMN, nullptr, Wxk, D, MT, D, D, 1 << 20, 0}; pg8::StaticOrder S; S.init(MT, D, F.G, (int)((blockIdx.x + 128) % F.G));
              pg8::EpiBf16<0> E{KX, D, 1.f, nullptr, nullptr, nullptr};
              pg8::gemm_phase<pg8::EpiBf16<0>, pg8::StaticOrder, true, true>(F.lds + RING_OFF, g, S, E); }
            PHASE_BEGIN();
            { pg8::Gemm g{MEMN, nullptr, Wxv, D, MT, D, D, 1 << 20, 0}; pg8::StaticOrder S; S.init(MT, D, F.G, (int)((blockIdx.x + 96) % F.G));
              pg8::EpiBf16T E{VX};
              pg8::gemm_phase<pg8::EpiBf16T, pg8::StaticOrder, true, true>(F.lds + RING_OFF, g, S, E); }
            SEAM(pb + 1);
        }
        if (IN(pb + 2)) { PHASE_BEGIN();
            { pg8::Gemm g{ZA, nullptr, Wmla, 1024, T, 1024, 512, 1 << 20, 0}; pg8::StaticOrder S; S.init(T, 1024, F.G, (int)blockIdx.x);
              pg8::EpiMla E{QB, KB, VB, SSQ, ROPEC, ROPES};
              pg8::gemm_phase<pg8::EpiMla, pg8::StaticOrder, true, true>(F.lds + RING_OFF, g, S, E); }
            PHASE_BEGIN();
            for (int chunk = F.vcu; chunk < T / 128; chunk += F.G) sg_chunk(F.lds + RING_OFF, chunk, F.tid, ZA, WSM, sg_ln_g + l * 256, sg_ln_b + l * 256, sg_b + (size_t)l * 512, BR);
        }
        if (IN(pb + 3)) { PHASE_BEGIN();
            if (F.wave < 4) { LAS float* Xk = (LAS float*)(F.lds + RING_OFF + F.wave * 34816); LAS float* Lm = Xk + 64 * XKS; const float* cw = dn_conv + (size_t)l * 4 * 768;
                for (int item = F.vcu * 4 + F.wave; item < 2048; item += F.G * 4) { const int h = item & 3; const int ln3 = (int)(threadIdx.x & 63u);
                    dn1_item(item, ln3, Xk, Lm, ZB, ZF, cw, __expf(dn_alog[l * 4 + h]), dn_dtb[l * 4 + h], XCb, WTb, KDTb, QDb, ATb, GLb); } }
            else { const float* wg = gla_wg + (size_t)l * 16 * 128; const float* bg = gla_bg + l * 128;
                for (int item = F.vcu * 4 + (F.wave - 4); item < 2048; item += F.G * 4) gla1_item(item, F.lane, ZB, ZF, wg, bg, BSb, EGb); }
            SEAM(pb + 3);
        }
        if (IN(pb + 4)) { PHASE_BEGIN();
            if (F.wave == 0) for (int w = F.vcu; w < 64; w += F.G) dn2_worker(w >> 1, w & 1, F.lane, XCb, WTb, KDTb, SNTb, GLb);
            for (int e = gtid - 64 * 512; e < 65536; e += NGT) if (e >= 0) { const int bh = e >> 11, kap = (e >> 6) & 31, v = e & 63, b = bh >> 2, h = bh & 3;
                float S = 0.f;
#pragma unroll 1
                for (int n0 = 0; n0 < 64; n0 += 32) { float Bn[32], Eg[32];
#pragma unroll
                    for (int n = 0; n < 32; ++n) { const int item = (b * 64 + n0 + n) * 4 + h; Bn[n] = BSb[(size_t)item * 2048 + kap * 64 + v]; Eg[n] = EGb[item * 32 + kap]; }
#pragma unroll
                    for (int n = 0; n < 32; ++n) { const int item = (b * 64 + n0 + n) * 4 + h; BSb[(size_t)item * 2048 + kap * 64 + v] = S; S = Eg[n] * (S + Bn[n]); } } }
            PHASE_BEGIN();
            __syncthreads();
            { unsigned* qctr = (unsigned*)(ctl + CW_Q + 64 * l); volatile LAS unsigned* qslot = MISC + 16;
              for (;;) { if (F.tid == 0) qslot[0] = __hip_atomic_fetch_add(qctr, 1u, __ATOMIC_RELAXED, __HIP_MEMORY_SCOPE_AGENT);
                  __syncthreads(); const unsigned u2 = qslot[0]; __syncthreads();
                  if (u2 >= 512u) break;
                  const int qb = 15 - (int)(u2 >> 5), bh = (int)(u2 & 31u);
                  attn_unit(F.lds + RING_OFF, bh >> 2, bh & 3, qb, F.tid, QB, KB, VB, BR); } }
            SEAM(pb + 4);
        }
        if (IN(pb + 5)) { PHASE_BEGIN();
            LAS float* Lw = (LAS float*)(F.lds + RING_OFF + F.wave * 17408);
            const float* wg = gla_wg + (size_t)l * 16 * 128; const float* bg = gla_bg + l * 128;
            const float gng = gla_norm[l * 64 + F.lane];
            for (int item = gw; item < 2048; item += NGW) {
                gla3m_item(item, F.lane, (LAS unsigned char*)Lw, ZB, ZF, wg, bg, BSb, gla_norm + l * 64, BR);
                dn3_item(item, F.lane, QDb, ATb, SNTb, WTb, ZB, dn_norm + l * 64, BR);
            }
            SEAM(pb + 5);
        }
        if (IN(pb + 6)) { PHASE_BEGIN();
            p6_phase(F.lds + RING_OFF, F.vcu, F.G, F.tid, BR, Wpj, PJ);
            SEAM(pb + 6);
        }
        if (IN(pb + 7)) { PHASE_BEGIN();
            pg8::Gemm g{HB, nullptr, Wmrg, D, T, 4096, D, 1 << 20, 0}; pg8::StaticOrder S; S.init(T, 4096, F.G, (int)blockIdx.x);
            pg8::EpiMerge E{MG, PJ, R1};
            pg8::gemm_phase<pg8::EpiMerge, pg8::StaticOrder, true, true>(F.lds + RING_OFF, g, S, E);
            SEAM(pb + 7);
        }
        if (IN(pb + 8)) { PHASE_BEGIN();
            pg8::Gemm g{MG, nullptr, Wout, D, T, D, D, 1 << 20, 0}; pg8::StaticOrder S; S.init(T, D, F.G, (int)blockIdx.x);
            pg8::EpiResF32 E{HB, D, SS16, nullptr};
            pg8::gemm_phase<pg8::EpiResF32, pg8::StaticOrder, true, true>(F.lds + RING_OFF, g, S, E);
            SEAM(pb + 8);
        }
        if (IN(pb + 9)) { PHASE_BEGIN();
            pg8::Gemm g{HB, nullptr, Wxq, D, T, D, D, 1 << 20, 0}; pg8::StaticOrder S; S.init(T, D, F.G, (int)blockIdx.x);
            { pg8::EpiBf16<0> E{XQ, D, 1.f, nullptr, nullptr, nullptr};
              pg8::gemm_phase<pg8::EpiBf16<0>, pg8::StaticOrder, true, true>(F.lds + RING_OFF, g, S, E); }
            PHASE_BEGIN();
            __syncthreads();
            { pg8::Unit u; for (int i = 0; S.next(i, u); ++i) xattn_unit(F.lds + RING_OFF, u.pm >> 4, u.pn, u.pm & 15, F.tid, XQ, KX, VX, XO, SS16); }
            SEAM(pb + 9);
        }
        if (IN(pb + 11)) { PHASE_BEGIN();
            pg8::Gemm g{XO, nullptr, Wxo, D, T, D, D, 1 << 20, 0}; pg8::StaticOrder S; S.init(T, D, F.G, (int)blockIdx.x);
            pg8::EpiResF32 E{HB, D, SS16B, nullptr};
            pg8::gemm_phase<pg8::EpiResF32, pg8::StaticOrder, true, true>(F.lds + RING_OFF, g, S, E);
            SEAM(pb + 11);
        }
        if (IN(pb + 13)) { PHASE_BEGIN();
            pg8::Gemm g{HB, nullptr, Wup, D, T, FF, D, 1 << 20, 0}; pg8::StaticOrder S; S.init(T, FF, F.G, (int)blockIdx.x);
            pg8::EpiBf16<2> E{HID, FF, 1.f, nullptr, SS16B, R1};
            pg8::gemm_phase<pg8::EpiBf16<2>, pg8::StaticOrder, true, true>(F.lds + RING_OFF, g, S, E);
            SEAM(pb + 13);
        }
        if (IN(pb + 14)) { PHASE_BEGIN();
            pg8::Gemm g{HID, nullptr, Wdn, FF, T, D, FF, 1 << 20, 0}; pg8::StaticOrder S; S.init(T, D, F.G, (int)blockIdx.x);
            pg8::EpiResF32 E{HB, D, SS16, R1};
            pg8::gemm_phase<pg8::EpiResF32, pg8::StaticOrder, true, true>(F.lds + RING_OFF, g, S, E);
            SEAM(pb + 14);
        }
    }
    if (IN(DEPTH * NPH_L)) { PHASE_BEGIN();
        for (int m = gw; m < T; m += NGW) { const float r = row_rscale(SS16, (size_t)m);
            const GAS unsigned long long* xr = (const GAS unsigned long long*)(HB + (size_t)m * D) + F.lane; const GAS f32x4* gr = (const GAS f32x4*)norm_final + F.lane; GAS f32x4* orow = (GAS f32x4*)(XR + (size_t)m * D) + F.lane;
#pragma unroll
            for (int j = 0; j < 4; ++j) { const unsigned long long w = xr[64 * j]; const unsigned lo = (unsigned)w, hi = (unsigned)(w >> 32); const f32x4 gg = gr[64 * j];
                orow[64 * j] = (f32x4){bflo(lo) * r * gg.x, bfhi(lo) * r * gg.y, bflo(hi) * r * gg.z, bfhi(hi) * r * gg.w}; } }
    }
#undef IN
#undef SEAM
}

extern "C" void kernel_launch(void* const* d_in, const int* in_sizes, int n_in, void* d_out, int out_size, void* d_ws, size_t ws_size, hipStream_t stream) {
    static int grid = 0;
    if (grid == 0) {
        if (n_in != 32 || out_size != T * D || ws_size < WS_END) { fprintf(stderr, "kernel_launch: unexpected shapes (n_in %d, out %d, ws %zu)\n", n_in, out_size, ws_size); grid = -1; return; }
        int dev = 0, cus = 0, per_cu = 0;
        if (hipGetDevice(&dev) != hipSuccess || hipDeviceGetAttribute(&cus, hipDeviceAttributeMultiprocessorCount, dev) != hipSuccess) { grid = -1; return; }
        if (hipFuncSetAttribute((const void*)skel_fwd, hipFuncAttributeMaxDynamicSharedMemorySize, LDS_BYTES) != hipSuccess) { fprintf(stderr, "kernel_launch: hipFuncSetAttribute failed\n"); grid = -1; return; }
        if (hipOccupancyMaxActiveBlocksPerMultiprocessor(&per_cu, (const void*)skel_fwd, NWAVES * 64, LDS_BYTES) != hipSuccess || per_cu < 1)
            fprintf(stderr, "kernel_launch: occupancy query reports %d workgroups per CU\n", per_cu);
        (void)hipGetLastError();
        grid = cus;
        if (grid > 256) grid = 256;
    }
    if (grid < 0) return;
    if (hipMemsetAsync((char*)d_ws + WS_CTL, 0, CTL_ZERO_BYTES, stream) != hipSuccess) return;
    Args a{};
    for (int i = 0; i < 32; ++i) a.in[i] = d_in[i];
    a.out = (float*)d_out; a.ws = (unsigned char*)d_ws;
#if MK_N_LAUNCHES == 1
    a.ph_lo = 0; a.ph_hi = NPHASES;
    hipLaunchKernelGGL(skel_fwd, dim3(grid), dim3(NWAVES * 64), LDS_BYTES, stream, a);
#else
    for (int p = 0; p < NPHASES; ++p) { a.ph_lo = p; a.ph_hi = p + 1; hipLaunchKernelGGL(skel_fwd, dim3(grid), dim3(NWAVES * 64), LDS_BYTES, stream, a); }
#endif
}
```
